# Optimizing an MI355X kernel written in HIP

```python
import jax, jax.numpy as jnp
from jax import lax
import numpy as np

D_MODEL = 1024
BATCH = 32
SEQ = 2048
DEPTH = 4
DEC_BATCH = 32
DEC_SEQ = 64
PAST_LEN = 4096

CHUNK = 64
D_MIX = D_MODEL
D_HGRN = D_MIX // 2
N_HGRN_HEADS = 4
HGRN_HEAD_DIM = D_HGRN // N_HGRN_HEADS
D_SGU = D_MIX - D_HGRN
N_SGU_HEADS = 4
SGU_HEAD_DIM = D_SGU // N_SGU_HEADS
SGU_CHUNK = 128
D_FF = 2816
FFN_RESIDUAL_WEIGHT = 0.5
D_IN = 4 * D_HGRN + 2 * D_SGU
EPS = 1e-6

kernel_name = "hybrid_hgrn2_gmlp_macaron_stream_step"


def rms_norm(x, g):
    x32 = x.astype(jnp.float32)
    y = x32 * lax.rsqrt(jnp.mean(x32 * x32, axis=-1, keepdims=True) + EPS)
    return (y * g.astype(jnp.float32)).astype(x.dtype)


def swiglu(x, w1, w3, w2):
    return (jax.nn.silu(x @ w1) * (x @ w3)) @ w2


def layer_lower_bounds(lb_logits):
    p = jax.nn.softmax(lb_logits.astype(jnp.float32), axis=0)
    return jnp.cumsum(p, axis=0) - p[0:1]


def gla_block_step(S, blk):
    q, k, v, logf = blk
    c = q.shape[2]
    b = jnp.cumsum(logf, axis=2)
    o_inter = jnp.einsum('bhtk,bhkv->bhtv', q * jnp.exp(b), S)
    mask = jnp.tril(jnp.ones((c, c), dtype=bool))[:, :, None]
    diff = b[:, :, :, None, :] - b[:, :, None, :, :]
    decay = jnp.exp(jnp.where(mask, diff, -jnp.inf))
    att = jnp.einsum('bhtk,bhtsk,bhsk->bhts', q, decay, k)
    o = o_inter + jnp.einsum('bhts,bhsv->bhtv', att, v)
    b_last = b[:, :, -1, :]
    S_new = jnp.exp(b_last)[..., None] * S + jnp.einsum(
        'bhsk,bhsv->bhkv', k * jnp.exp(b_last[:, :, None, :] - b), v)
    return S_new, o


def hgrn2_mixer(zq, zf, zi, zg, lb, out_gain, S0):
    B, L, _ = zq.shape
    H, Dh = N_HGRN_HEADS, HGRN_HEAD_DIM
    heads = lambda t: t.astype(jnp.float32).reshape(B, L, H, Dh)
    q = jax.nn.silu(heads(zq)) * (Dh ** -0.5)
    f = lb.reshape(H, Dh) + (1.0 - lb.reshape(H, Dh)) * jax.nn.sigmoid(heads(zf))
    logf = jnp.log(f)
    k = 1.0 - f
    v = heads(zi)
    c = min(L, CHUNK)
    n = L // c
    to_blocks = lambda t: t.reshape(B, n, c, H, Dh).transpose(1, 0, 3, 2, 4)
    S_fin, o = lax.scan(gla_block_step, S0, (to_blocks(q), to_blocks(k), to_blocks(v), to_blocks(logf)))
    o = o.transpose(1, 0, 3, 2, 4).reshape(B, L, H, Dh)
    o = o * lax.rsqrt(jnp.mean(o * o, axis=-1, keepdims=True) + EPS) * out_gain.astype(jnp.float32).reshape(H, Dh)
    o = o * jax.nn.silu(heads(zg))
    return o.reshape(B, L, D_HGRN).astype(zq.dtype), S_fin


def sgu_mixer(zu, zv, ln_g, ln_b, w_s, b_s):
    B, L, _ = zu.shape
    Hs, Ch = N_SGU_HEADS, SGU_HEAD_DIM
    c = min(L, SGU_CHUNK)
    n = L // c
    u = jax.nn.gelu(zu).reshape(B, L, Hs, Ch)
    v = jax.nn.gelu(zv).astype(jnp.float32).reshape(B, L, Hs, Ch)
    mu = jnp.mean(v, axis=-1, keepdims=True)
    var = jnp.mean(jnp.square(v - mu), axis=-1, keepdims=True)
    vn = (v - mu) * lax.rsqrt(var + EPS) * ln_g.astype(jnp.float32).reshape(Hs, Ch) \
        + ln_b.astype(jnp.float32).reshape(Hs, Ch)
    vn = vn.astype(zu.dtype)
    ws = jnp.tril(w_s[:, :c, :c])
    mixed = jnp.einsum('hts,bnshd->bnthd', ws, vn.reshape(B, n, c, Hs, Ch)) \
        + b_s[:, :c].T[None, None, :, :, None]
    out = u * mixed.reshape(B, L, Hs, Ch)
    return out.reshape(B, L, D_SGU), vn.reshape(B, L, D_SGU)


def trunk(x, S0_stack, lbs, norm_ffn1, ffn1_w1, ffn1_w3, ffn1_w2, norm_mix, w_in, hgrn_out_norm,
          sgu_ln_g, sgu_ln_b, sgu_w_s, sgu_b_s, w_out, norm_ffn2, ffn2_w1, ffn2_w3, ffn2_w2, final_norm):
    states, vrows = [], []
    cuts = [D_HGRN, 2 * D_HGRN, 3 * D_HGRN, 4 * D_HGRN, 4 * D_HGRN + D_SGU]
    for l in range(DEPTH):
        x = x + FFN_RESIDUAL_WEIGHT * swiglu(rms_norm(x, norm_ffn1[l]), ffn1_w1[l], ffn1_w3[l], ffn1_w2[l])
        h = rms_norm(x, norm_mix[l])
        zq, zf, zi, zg, zu, zv = jnp.split(h @ w_in[l], cuts, axis=-1)
        o_a, S = hgrn2_mixer(zq, zf, zi, zg, lbs[l], hgrn_out_norm[l], S0_stack[l].astype(jnp.float32))
        o_b, vn = sgu_mixer(zu, zv, sgu_ln_g[l], sgu_ln_b[l], sgu_w_s[l], sgu_b_s[l])
        x = x + jnp.concatenate([o_a, o_b.astype(o_a.dtype)], axis=-1) @ w_out[l]
        x = x + FFN_RESIDUAL_WEIGHT * swiglu(rms_norm(x, norm_ffn2[l]), ffn2_w1[l], ffn2_w3[l], ffn2_w2[l])
        states.append(S)
        vrows.append(vn)
    return rms_norm(x, final_norm), jnp.stack(states), jnp.stack(vrows)


def setup_inputs(seed: int = 0) -> dict:
    key = jax.random.key(seed)
    ks = jax.random.split(key, 24)
    f32 = jnp.float32
    nrm = lambda k, shape, s: jax.random.normal(k, shape, f32) * s
    gain = lambda k, shape: 1.0 + 0.02 * jax.random.normal(k, shape, f32)
    return {
        "x_prompt": nrm(ks[0], (BATCH, SEQ, D_MODEL), 1.0),
        "x_sample": nrm(ks[1], (DEC_BATCH, DEC_SEQ, D_MODEL), 1.0),
        "state_hgrn": nrm(ks[2], (DEPTH, DEC_BATCH, N_HGRN_HEADS, HGRN_HEAD_DIM, HGRN_HEAD_DIM), 0.5),
        "lb_logits": nrm(ks[3], (DEPTH, D_HGRN), 1.0),
        "norm_ffn1": gain(ks[4], (DEPTH, D_MODEL)),
        "ffn1_w1": nrm(ks[5], (DEPTH, D_MODEL, D_FF), D_MODEL ** -0.5),
        "ffn1_w3": nrm(ks[6], (DEPTH, D_MODEL, D_FF), D_MODEL ** -0.5),
        "ffn1_w2": nrm(ks[7], (DEPTH, D_FF, D_MODEL), D_FF ** -0.5),
        "norm_mix": gain(ks[8], (DEPTH, D_MODEL)),
        "w_in": nrm(ks[9], (DEPTH, D_MODEL, D_IN), D_MODEL ** -0.5),
        "hgrn_out_norm": gain(ks[10], (DEPTH, D_HGRN)),
        "sgu_ln_g": gain(ks[11], (DEPTH, D_SGU)),
        "sgu_ln_b": nrm(ks[12], (DEPTH, D_SGU), 0.02),
        "sgu_w_s": nrm(ks[13], (DEPTH, N_SGU_HEADS, SGU_CHUNK, SGU_CHUNK), SGU_CHUNK ** -0.5),
        "sgu_b_s": gain(ks[14], (DEPTH, N_SGU_HEADS, SGU_CHUNK)),
        "w_out": nrm(ks[15], (DEPTH, D_MIX, D_MODEL), D_MIX ** -0.5),
        "norm_ffn2": gain(ks[16], (DEPTH, D_MODEL)),
        "ffn2_w1": nrm(ks[17], (DEPTH, D_MODEL, D_FF), D_MODEL ** -0.5),
        "ffn2_w3": nrm(ks[18], (DEPTH, D_MODEL, D_FF), D_MODEL ** -0.5),
        "ffn2_w2": nrm(ks[19], (DEPTH, D_FF, D_MODEL), D_FF ** -0.5),
        "final_norm": gain(ks[20], (D_MODEL,)),
    }


def reference(x_prompt, x_sample, state_hgrn, lb_logits, norm_ffn1, ffn1_w1, ffn1_w3, ffn1_w2, norm_mix,
              w_in, hgrn_out_norm, sgu_ln_g, sgu_ln_b, sgu_w_s, sgu_b_s, w_out, norm_ffn2, ffn2_w1,
              ffn2_w3, ffn2_w2, final_norm):
    lbs = layer_lower_bounds(lb_logits)
    weights = (norm_ffn1, ffn1_w1, ffn1_w3, ffn1_w2, norm_mix, w_in, hgrn_out_norm, sgu_ln_g, sgu_ln_b,
               sgu_w_s, sgu_b_s, w_out, norm_ffn2, ffn2_w1, ffn2_w3, ffn2_w2, final_norm)
    zeros = jnp.zeros((DEPTH, x_prompt.shape[0], N_HGRN_HEADS, HGRN_HEAD_DIM, HGRN_HEAD_DIM), jnp.float32)
    y_prompt, s_prompt, _ = trunk(x_prompt, zeros, lbs, *weights)
    y_sample, s_sample, v_sample = trunk(x_sample, state_hgrn, lbs, *weights)
    state_hgrn_prompt = s_prompt.astype(x_prompt.dtype)
    state_hgrn_sample = s_sample.astype(state_hgrn.dtype)
    state_sgu_v_sample = v_sample.astype(x_sample.dtype)
    return (y_prompt, y_sample, state_hgrn_prompt, state_hgrn_sample, state_sgu_v_sample)
```

```cpp
#include <hip/hip_runtime.h>
#include <hip/hip_cooperative_groups.h>
#include <cstdio>
#include <cstdint>
namespace cg = cooperative_groups;
namespace pg8 {
#define PG8_LAS __attribute__((address_space(3)))
typedef unsigned short bf16_t;
typedef short bf16x8 __attribute__((ext_vector_type(8)));
typedef float f32x4 __attribute__((ext_vector_type(4)));
typedef unsigned u32x4 __attribute__((ext_vector_type(4)));
constexpr int BM = 256, BK = 64, HALF = 128, HTB = HALF * BK * 2  , STAGE_BYTES = 8 * HTB, NXCD = 8, WGM = 8;

__host__ __device__ __forceinline__ int lds_byte(int r, int c) { const int st = (r >> 4) * 2 + (c >> 5), rr = r & 15, cc = c & 31, ob = rr * 64 + cc * 2; return st * 1024 + (ob ^ (((ob >> 9) & 1) << 5)); }
__host__ __device__ __forceinline__ void stage_rc(int b, int& R, int& C) { const int st = b / 1024, sb = b % 1024, swz = sb ^ (((sb >> 9) & 1) << 5); R = (st >> 1) * 16 + swz / 64; C = (st & 1) * 32 + (swz % 64) / 2; }
__host__ __device__ __forceinline__ int perm32(int rho) { const int n = rho >> 4, i = rho & 15; return 8 * (i >> 2) + 4 * n + (i & 3); }

struct Unit { int pm, pn; };
struct Gemm { const bf16_t* A; const bf16_t* Bt; int M, N, K; };

struct StaticOrder {
    int nM, nN, nwg, G, c;
    __host__ __device__ void init(int M, int N, int G_, int c_) { nM = M / BM; nN = N / BM; nwg = nM * nN; G = G_; c = c_; }
    __host__ __device__ bool next(int i, Unit& u) const {
        const long L = (long)i * G + c; if (L >= nwg) return false;
        int wgid = (int)L; { const int q = nwg / NXCD, r = nwg % NXCD, xcd = wgid % NXCD, off = wgid / NXCD; wgid = (xcd < r ? xcd * (q + 1) : r * (q + 1) + (xcd - r) * q) + off; }
        const int nig = WGM * nN, gid = wgid / nig, fm = gid * WGM, gsz = (nM - fm) < WGM ? (nM - fm) : WGM;
        u.pm = fm + ((wgid % nig) % gsz); u.pn = (wgid % nig) / gsz; return true;
    }
    __device__ __forceinline__ void a_ready(const Unit&) const {}
    __device__ __forceinline__ void done(const Unit&) const {}
};
__device__ __forceinline__ unsigned cvt_pk_bf16(float lo, float hi) { unsigned r; asm volatile("v_cvt_pk_bf16_f32 %0, %1, %2" : "=v"(r) : "v"(lo), "v"(hi)); return r; }
typedef unsigned u32x2 __attribute__((ext_vector_type(2)));
constexpr float RMS_EPS = 1e-6f;
__device__ __forceinline__ float silu_f(float x) { return x / (1.0f + __expf(-x)); }

__device__ __forceinline__ float row_rstd(const float* ssq, int row) {
    const f32x4* sp = (const f32x4*)(ssq + (size_t)row * 16); const f32x4 a = (sp[0] + sp[1]) + (sp[2] + sp[3]);
    return rsqrtf(((a[0] + a[1]) + (a[2] + a[3])) * (1.0f / 1024.0f) + RMS_EPS);
}
struct EpiSwiglu {
    static constexpr bool PERM = true, AFTER_DRAIN = false;
    bf16_t* O; int ldc; const float* ssq;
    __device__ __forceinline__ void operator()(const f32x4 (&acc)[2][2][4][2], const Unit& u, int wr, int wc, int fr, int fq) const {
        const int row0 = u.pm * BM + wr * 64 + fr, col0 = u.pn * HALF + wc * 32 + 8 * fq;
#pragma unroll
        for (int ai = 0; ai < 2; ++ai)
#pragma unroll
            for (int m = 0; m < 4; ++m) {
                const int row = row0 + ai * HALF + m * 16;
                const float rs = row_rstd(ssq, row);
                float o[8];
#pragma unroll
                for (int n = 0; n < 2; ++n)
#pragma unroll
                    for (int j = 0; j < 4; ++j) { const float a = acc[ai][0][m][n][j] * rs, b = acc[ai][1][m][n][j] * rs; o[n * 4 + j] = silu_f(a) * b; }
                u32x4 w; w.x = cvt_pk_bf16(o[0], o[1]); w.y = cvt_pk_bf16(o[2], o[3]); w.z = cvt_pk_bf16(o[4], o[5]); w.w = cvt_pk_bf16(o[6], o[7]);
                *(u32x4*)(O + (size_t)row * ldc + col0) = w;
            }
    }
};
struct EpiScale {
    static constexpr bool PERM = true, AFTER_DRAIN = false;
    bf16_t* O; int ldc; const float* ssq;
    __device__ __forceinline__ void operator()(const f32x4 (&acc)[2][2][4][2], const Unit& u, int wr, int wc, int fr, int fq) const {
        const int row0 = u.pm * BM + wr * 64 + fr, col0 = u.pn * BM + wc * 32 + 8 * fq;
#pragma unroll
        for (int ai = 0; ai < 2; ++ai)
#pragma unroll
            for (int m = 0; m < 4; ++m) {
                const int row = row0 + ai * HALF + m * 16;
                const float rs = row_rstd(ssq, row);
#pragma unroll
                for (int bj = 0; bj < 2; ++bj) {
                    const f32x4 v0 = acc[ai][bj][m][0] * rs, v1 = acc[ai][bj][m][1] * rs;
                    u32x4 w; w.x = cvt_pk_bf16(v0[0], v0[1]); w.y = cvt_pk_bf16(v0[2], v0[3]); w.z = cvt_pk_bf16(v1[0], v1[1]); w.w = cvt_pk_bf16(v1[2], v1[3]);
                    *(u32x4*)(O + (size_t)row * ldc + col0 + bj * HALF) = w;
                }
            }
    }
};
struct EpiResid {
    static constexpr bool PERM = false, AFTER_DRAIN = false;
    float* X; bf16_t* XG; const float* g; float* ssq; float scale;
    __device__ __forceinline__ void operator()(const f32x4 (&acc)[2][2][4][2], const Unit& u, int wr, int wc, int fr, int fq) const {
        const int row0 = u.pm * BM + wr * 64 + fr, col0 = u.pn * BM + wc * 32 + 4 * fq;
        f32x4 gv[2][2];
#pragma unroll
        for (int bj = 0; bj < 2; ++bj)
#pragma unroll
            for (int n = 0; n < 2; ++n) gv[bj][n] = *(const f32x4*)(g + col0 + bj * HALF + n * 16);
#pragma unroll
        for (int ai = 0; ai < 2; ++ai)
#pragma unroll
            for (int m = 0; m < 4; ++m) {
                const int row = row0 + ai * HALF + m * 16;
                float* xr = X + (size_t)row * 1024 + col0; bf16_t* gr = XG + (size_t)row * 1024 + col0;
                float ss = 0.f;
#pragma unroll
                for (int bj = 0; bj < 2; ++bj)
#pragma unroll
                    for (int n = 0; n < 2; ++n) {
                        f32x4 x = *(const f32x4*)(xr + bj * HALF + n * 16);
                        x = x + acc[ai][bj][m][n] * scale;
                        *(f32x4*)(xr + bj * HALF + n * 16) = x;
                        ss += (x[0] * x[0] + x[1] * x[1]) + (x[2] * x[2] + x[3] * x[3]);
                        const f32x4 y = x * gv[bj][n];
                        u32x2 w; w.x = cvt_pk_bf16(y[0], y[1]); w.y = cvt_pk_bf16(y[2], y[3]);
                        *(u32x2*)(gr + bj * HALF + n * 16) = w;
                    }
                ss += __shfl_xor(ss, 16); ss += __shfl_xor(ss, 32);
                if (fq == 0) ssq[(size_t)row * 16 + u.pn * 4 + wc] = ss;
            }
    }
};
template <class Epi, class Sched, bool ALIGN_EPI = false, bool SP2 = false>
__device__ __forceinline__ void gemm_phase(PG8_LAS unsigned char* lds, const Gemm g, const Sched& S, const Epi& E) {
    int tid_ = threadIdx.x; asm volatile("" : "+v"(tid_));
    const int tid = tid_, wid = __builtin_amdgcn_readfirstlane(tid >> 6), lane = tid & 63, wr = wid >> 2, wc = wid & 3, fr = lane & 15, fq = lane >> 4;
    const int K = g.K, nt = K / BK;
    unsigned voffA[2], voffB[2];
#pragma unroll
    for (int i = 0; i < 2; ++i) { int R, C; stage_rc(tid * 16 + i * 8192, R, C); const int Rb = Epi::PERM ? ((R & ~31) + perm32(R & 31)) : R;
        voffA[i] = (unsigned)(R * K + C) * 2u; voffB[i] = (unsigned)(Rb * K + C) * 2u; }
    const size_t kstep = (size_t)(BK * 2);
    const size_t hstep = (size_t)HALF * K * 2;
    const size_t tstep = 2 * hstep;
    const unsigned ldsw = (unsigned)wid * 1024u;
    const int aoff = lds_byte(wr * 64 + fr, fq * 8), boff = lds_byte(wc * 32 + fr, fq * 8);
#define PG8_SA(b, h) (((b) * 2 + (h)) * HTB)
#define PG8_SB(b, h) ((4 + (b) * 2 + (h)) * HTB)
#define PG8_STAGE(bufoff, gbase, voff) do { _Pragma("unroll") for (int _i = 0; _i < 2; ++_i) \
        __builtin_amdgcn_global_load_lds((const unsigned*)((const char*)(gbase) + (voff)[_i]), (PG8_LAS unsigned*)(lds + (bufoff) + ldsw + _i * 8192), 16, 0, 0); } while (0)
#define PG8_LDA(dst, b, h) do { _Pragma("unroll") for (int m = 0; m < 4; ++m) _Pragma("unroll") for (int k = 0; k < 2; ++k) dst[m][k] = *(const PG8_LAS bf16x8*)(lds + PG8_SA(b, h) + aoff + m * 2048 + k * 1024); } while (0)
#define PG8_LDB(dst, b, h) do { _Pragma("unroll") for (int n = 0; n < 2; ++n) _Pragma("unroll") for (int k = 0; k < 2; ++k) dst[n][k] = *(const PG8_LAS bf16x8*)(lds + PG8_SB(b, h) + boff + n * 2048 + k * 1024); } while (0)
#define PG8_MMA(ai, bj, At, Bt) do { __builtin_amdgcn_s_setprio(1); _Pragma("unroll") for (int m = 0; m < 4; ++m) _Pragma("unroll") for (int n = 0; n < 2; ++n) _Pragma("unroll") for (int k = 0; k < 2; ++k) \
        acc[ai][bj][m][n] = __builtin_amdgcn_mfma_f32_16x16x32_bf16(Bt[n][k], At[m][k], acc[ai][bj][m][n], 0, 0, 0); __builtin_amdgcn_s_setprio(0); } while (0)
#define PG8_WAIT_V(n) asm volatile("s_waitcnt vmcnt(" #n ")" ::: "memory")
#define PG8_WAIT_L(n) asm volatile("s_waitcnt lgkmcnt(" #n ")" ::: "memory")
#define PG8_BAR __builtin_amdgcn_s_barrier()
#define PG8_SCHED __builtin_amdgcn_sched_barrier(0)
    Unit cur, nxt; int ui = 0;
    if (!S.next(0, cur)) return;
    f32x4 acc[2][2][4][2];
#pragma unroll
    for (int a = 0; a < 2; ++a)
#pragma unroll
        for (int b = 0; b < 2; ++b)
#pragma unroll
            for (int m = 0; m < 4; ++m)
#pragma unroll
                for (int n = 0; n < 2; ++n) acc[a][b][m][n] = (f32x4){0.f, 0.f, 0.f, 0.f};
    bf16x8 At[4][2], B0[2][2], B1[2][2];
    const char* cA = (const char*)g.A + (size_t)cur.pm * tstep; const char* cB = (const char*)g.Bt + (size_t)cur.pn * tstep;
    S.a_ready(cur);
    if constexpr (SP2) {
        PG8_STAGE(PG8_SB(0, 0), cB, voffB); PG8_STAGE(PG8_SB(0, 1), cB + hstep, voffB); PG8_STAGE(PG8_SA(0, 0), cA, voffA); PG8_STAGE(PG8_SA(0, 1), cA + hstep, voffA);
        if (wr == 1) PG8_BAR;
        PG8_WAIT_V(2); PG8_BAR;
        PG8_STAGE(PG8_SB(1, 0), cB + kstep, voffB); PG8_STAGE(PG8_SA(1, 0), cA + kstep, voffA); PG8_STAGE(PG8_SB(1, 1), cB + hstep + kstep, voffB);
        PG8_WAIT_V(6); PG8_BAR;
    } else {
        PG8_STAGE(PG8_SB(0, 0), cB, voffB); PG8_STAGE(PG8_SA(0, 0), cA, voffA); PG8_STAGE(PG8_SB(0, 1), cB + hstep, voffB); PG8_STAGE(PG8_SA(0, 1), cA + hstep, voffA);
        if (wr == 1) PG8_BAR;
        PG8_WAIT_V(4); PG8_BAR;
        PG8_STAGE(PG8_SB(1, 0), cB + kstep, voffB); PG8_STAGE(PG8_SA(1, 0), cA + kstep, voffA); PG8_STAGE(PG8_SB(1, 1), cB + hstep + kstep, voffB);
        PG8_WAIT_V(6); PG8_BAR;
    }
    for (;;) {
        const bool has_next = S.next(ui + 1, nxt);
        const char* nA = has_next ? (const char*)g.A + (size_t)nxt.pm * tstep : cA; const char* nB = has_next ? (const char*)g.Bt + (size_t)nxt.pn * tstep : cB;
        for (int t = 0; t < nt; t += 2) {
            const bool last = (t == nt - 2);
            const char* a1 = cA + (size_t)(t + 1) * kstep;
            const char* a2 = last ? nA : cA + (size_t)(t + 2) * kstep; const char* b2 = last ? nB : cB + (size_t)(t + 2) * kstep;
            const char* a3 = a2 + kstep; const char* b3 = b2 + kstep;
            if (last && has_next) S.a_ready(nxt);
            if constexpr (SP2) {
            PG8_LDB(B0, 0, 0); PG8_LDB(B1, 0, 1); PG8_SCHED; PG8_LDA(At, 0, 0); PG8_STAGE(PG8_SA(1, 1), a1 + hstep, voffA);
            PG8_WAIT_V(8); PG8_WAIT_L(0); PG8_BAR; PG8_MMA(0, 0, At, B0); PG8_MMA(0, 1, At, B1); PG8_BAR; PG8_SCHED;
            PG8_LDA(At, 0, 1); PG8_STAGE(PG8_SB(0, 0), b2, voffB); PG8_STAGE(PG8_SB(0, 1), b2 + hstep, voffB); PG8_STAGE(PG8_SA(0, 0), a2, voffA);
            PG8_WAIT_V(8); PG8_WAIT_L(0); PG8_BAR; PG8_MMA(1, 0, At, B0); PG8_MMA(1, 1, At, B1); PG8_BAR; PG8_SCHED;
            PG8_LDB(B0, 1, 0); PG8_LDB(B1, 1, 1); PG8_SCHED; PG8_LDA(At, 1, 0); PG8_STAGE(PG8_SA(0, 1), a2 + hstep, voffA);
            PG8_WAIT_V(8); PG8_WAIT_L(0); PG8_BAR; PG8_MMA(0, 0, At, B0); PG8_MMA(0, 1, At, B1); PG8_BAR; PG8_SCHED;
            PG8_LDA(At, 1, 1); PG8_STAGE(PG8_SB(1, 0), b3, voffB); PG8_STAGE(PG8_SB(1, 1), b3 + hstep, voffB); PG8_STAGE(PG8_SA(1, 0), a3, voffA);
            PG8_WAIT_V(8); PG8_WAIT_L(0); PG8_BAR; PG8_MMA(1, 0, At, B0); PG8_MMA(1, 1, At, B1); PG8_BAR; PG8_SCHED;
            } else {
            PG8_LDB(B0, 0, 0); PG8_SCHED; PG8_LDA(At, 0, 0); PG8_STAGE(PG8_SA(1, 1), a1 + hstep, voffA);
            PG8_WAIT_L(8); PG8_BAR; PG8_WAIT_L(0); PG8_MMA(0, 0, At, B0); PG8_BAR; PG8_SCHED;
            PG8_LDB(B1, 0, 1); PG8_STAGE(PG8_SB(0, 0), b2, voffB);
            PG8_BAR; PG8_WAIT_L(0); PG8_MMA(0, 1, At, B1); PG8_BAR;
            PG8_LDA(At, 0, 1); PG8_STAGE(PG8_SA(0, 0), a2, voffA);
            PG8_BAR; PG8_WAIT_L(0); PG8_MMA(1, 0, At, B0); PG8_BAR; PG8_SCHED;
            PG8_STAGE(PG8_SB(0, 1), b2 + hstep, voffB);
            PG8_WAIT_V(6); PG8_BAR; PG8_MMA(1, 1, At, B1); PG8_BAR;
            PG8_LDB(B0, 1, 0); PG8_SCHED; PG8_LDA(At, 1, 0); PG8_STAGE(PG8_SA(0, 1), a2 + hstep, voffA);
            PG8_WAIT_L(8); PG8_BAR; PG8_WAIT_L(0); PG8_MMA(0, 0, At, B0); PG8_BAR; PG8_SCHED;
            PG8_LDB(B1, 1, 1); PG8_STAGE(PG8_SB(1, 0), b3, voffB);
            PG8_BAR; PG8_WAIT_L(0); PG8_MMA(0, 1, At, B1); PG8_BAR;
            PG8_LDA(At, 1, 1); PG8_STAGE(PG8_SA(1, 0), a3, voffA);
            PG8_BAR; PG8_WAIT_L(0); PG8_MMA(1, 0, At, B0); PG8_BAR; PG8_SCHED;
            PG8_STAGE(PG8_SB(1, 1), b3 + hstep, voffB);
            PG8_WAIT_V(6); PG8_BAR; PG8_MMA(1, 1, At, B1); PG8_BAR;
            }
        }
        if constexpr (ALIGN_EPI) { if (wr == 0) PG8_BAR; }
        if constexpr (!Epi::AFTER_DRAIN) { E(acc, cur, wr, wc, fr, fq); S.done(cur); }
        if (!has_next) break;
#pragma unroll
        for (int a = 0; a < 2; ++a)
#pragma unroll
            for (int b = 0; b < 2; ++b)
#pragma unroll
                for (int m = 0; m < 4; ++m)
#pragma unroll
                    for (int n = 0; n < 2; ++n) acc[a][b][m][n] = (f32x4){0.f, 0.f, 0.f, 0.f};
        cur = nxt; cA = nA; cB = nB; ++ui;
        if constexpr (ALIGN_EPI) { if (wr == 1) PG8_BAR; }
    }
    PG8_WAIT_V(0);
    if constexpr (!ALIGN_EPI) { if (wr == 0) PG8_BAR; }
    PG8_BAR;
    if constexpr (Epi::AFTER_DRAIN) { E.fused(acc, cur, wr, wc, fr, fq, lds, wid, lane); S.done(cur); }
#undef PG8_SA
#undef PG8_SB
#undef PG8_STAGE
#undef PG8_LDA
#undef PG8_LDB
#undef PG8_MMA
#undef PG8_WAIT_V
#undef PG8_WAIT_L
#undef PG8_BAR
#undef PG8_SCHED
}
}

#define LAS __attribute__((address_space(3)))
typedef unsigned short bf16;
typedef float f32x4 __attribute__((ext_vector_type(4)));
typedef short bf16x8 __attribute__((ext_vector_type(8)));
typedef unsigned u32x4 __attribute__((ext_vector_type(4)));
typedef unsigned u32x2 __attribute__((ext_vector_type(2)));

constexpr int DM = 1024, DFF = 2816, DIN = 3072, NL = 4;
constexpr int MP = 65536, MSMP = 2048, MROWS = MP + MSMP;
constexpr int NTHREADS = 512, NWAVES = 8;
constexpr int LDS_BYTES = 147456;
constexpr float EPS = 1e-6f;
constexpr size_t SZ_W13 = (size_t)2 * DFF * DM * 2, SZ_W2 = (size_t)DM * DFF * 2, SZ_WIN = (size_t)DIN * DM * 2, SZ_WOUT = (size_t)DM * DM * 2;
constexpr size_t OFF_W13A = 0, OFF_W2A = OFF_W13A + SZ_W13, OFF_WIN = OFF_W2A + SZ_W2, OFF_WOUT = OFF_WIN + SZ_WIN, OFF_W13B = OFF_WOUT + SZ_WOUT, OFF_W2B = OFF_W13B + SZ_W13;
constexpr size_t SZ_WLAYER = OFF_W2B + SZ_W2;
constexpr size_t WS_W = 0;
constexpr size_t WS_XG = ((WS_W + NL * SZ_WLAYER + 4095) / 4096) * 4096;
constexpr size_t WS_Z = WS_XG + (size_t)MROWS * DM * 2;
constexpr size_t WS_O = WS_Z + (size_t)MROWS * DIN * 2;
constexpr size_t WS_SSQ = WS_O + (size_t)MROWS * DM * 2;
constexpr size_t WS_CTR = WS_SSQ + (size_t)13 * MROWS * 16 * 4;
constexpr size_t WS_END = WS_CTR + 4096;
constexpr size_t OUT_STP = (size_t)MROWS * DM, OUT_STS = OUT_STP + (size_t)NL * 32 * 4 * 128 * 128, OUT_VS = OUT_STS + (size_t)NL * 32 * 4 * 128 * 128;

struct Params {
    const float *x_prompt, *x_sample, *state_in, *lb_logits, *norm_ffn1, *f1w1, *f1w3, *f1w2, *norm_mix, *w_in, *hgrn_gain, *sgu_g, *sgu_b, *sgu_w, *sgu_bs, *w_out, *norm_ffn2, *f2w1, *f2w3, *f2w2, *final_norm;
    float* out; unsigned char* ws;
};

__device__ __forceinline__ float bf2f(bf16 v) { return __uint_as_float(((unsigned)v) << 16); }
__device__ __forceinline__ unsigned f2bf(float f) { unsigned u = __float_as_uint(f); return (u + 0x7fffu + ((u >> 16) & 1u)) >> 16; }
__device__ __forceinline__ unsigned pk2(float lo, float hi) { return pg8::cvt_pk_bf16(lo, hi); }
__device__ __forceinline__ float lo_f(unsigned w) { return __uint_as_float(w << 16); }
__device__ __forceinline__ float hi_f(unsigned w) { return __uint_as_float(w & 0xffff0000u); }
__device__ __forceinline__ float silu_f(float x) { return x / (1.0f + __expf(-x)); }
__device__ __forceinline__ float gelu_f(float x) { const float u = 1.5957691216f * (x + 0.044715f * x * x * x); return x / (1.0f + __expf(-u)); }
__device__ __forceinline__ float wave_sum(float v) {
#pragma unroll
    for (int o = 1; o < 64; o <<= 1) v += __shfl_xor(v, o);
    return v;
}
#define LDS_WAIT() asm volatile("s_waitcnt lgkmcnt(0)" ::: "memory")
#define MFMA16(a, b, c) __builtin_amdgcn_mfma_f32_16x16x32_bf16((a), (b), (c), 0, 0, 0)

__device__ __forceinline__ void tr_item(const float* W, int K, int N, bf16* WT, int k0, int n0, int drow0, LAS float* scr, int lane) {
#pragma unroll 8
    for (int i = 0; i < 32; ++i) { const int kk = 2 * i + (lane >> 5); scr[kk * 33 + (lane & 31)] = W[(size_t)(k0 + kk) * N + n0 + (lane & 31)]; }
    LDS_WAIT();
    const int c = lane & 7;
#pragma unroll
    for (int j = 0; j < 4; ++j) { const int n = (lane >> 3) + 8 * j; const LAS float* s = scr + (8 * c) * 33 + n;
        u32x4 o; o.x = pk2(s[0 * 33], s[1 * 33]); o.y = pk2(s[2 * 33], s[3 * 33]); o.z = pk2(s[4 * 33], s[5 * 33]); o.w = pk2(s[6 * 33], s[7 * 33]);
        *(u32x4*)(WT + (size_t)(drow0 + n) * K + k0 + 8 * c) = o; }
    LDS_WAIT();
}
__device__ __forceinline__ void prologue(LAS unsigned char* lds, const Params& p) {
    int tid_ = threadIdx.x; asm volatile("" : "+v"(tid_)); const int tid = tid_, lane = tid & 63, wave = tid >> 6;
    const int gw = blockIdx.x * NWAVES + wave, NGW = gridDim.x * NWAVES;
    LAS float* scr = (LAS float*)(lds + wave * 16384);
    constexpr int I_UP = (DM / 64) * (DFF / 32), I_DN = (DFF / 64) * (DM / 32), I_IN = (DM / 64) * (DIN / 32), I_OUT = (DM / 64) * (DM / 32);
    constexpr int I_LAYER = 6 * I_UP + I_IN + I_OUT;
    static_assert(I_UP == I_DN, "item counts");
    for (int it = gw; it < NL * I_LAYER; it += NGW) {
        const int l = it / I_LAYER; int r = it % I_LAYER;
        bf16* wl = (bf16*)(p.ws + WS_W + (size_t)l * SZ_WLAYER);
        const size_t oup = (size_t)l * DM * DFF, oin = (size_t)l * DM * DIN, oout = (size_t)l * DM * DM;
        if (r < 2 * I_UP) {
            const int w3 = r >= I_UP; r -= w3 * I_UP; const int kb = r / (DFF / 32), nb = r % (DFF / 32), n0 = 32 * nb;
            tr_item((w3 ? p.f1w3 : p.f1w1) + oup, DM, DFF, (bf16*)((unsigned char*)wl + OFF_W13A), 64 * kb, n0, (n0 >> 7) * 256 + (n0 & 127) + w3 * 128 - 0, scr, lane); continue; }
        r -= 2 * I_UP;
        if (r < I_DN) { const int kb = r / (DM / 32), nb = r % (DM / 32); tr_item(p.f1w2 + oup, DFF, DM, (bf16*)((unsigned char*)wl + OFF_W2A), 64 * kb, 32 * nb, 32 * nb, scr, lane); continue; }
        r -= I_DN;
        if (r < I_IN) { const int kb = r / (DIN / 32), nb = r % (DIN / 32); tr_item(p.w_in + oin, DM, DIN, (bf16*)((unsigned char*)wl + OFF_WIN), 64 * kb, 32 * nb, 32 * nb, scr, lane); continue; }
        r -= I_IN;
        if (r < I_OUT) { const int kb = r / (DM / 32), nb = r % (DM / 32); tr_item(p.w_out + oout, DM, DM, (bf16*)((unsigned char*)wl + OFF_WOUT), 64 * kb, 32 * nb, 32 * nb, scr, lane); continue; }
        r -= I_OUT;
        if (r < 2 * I_UP) {
            const int w3 = r >= I_UP; r -= w3 * I_UP; const int kb = r / (DFF / 32), nb = r % (DFF / 32), n0 = 32 * nb;
            tr_item((w3 ? p.f2w3 : p.f2w1) + oup, DM, DFF, (bf16*)((unsigned char*)wl + OFF_W13B), 64 * kb, n0, (n0 >> 7) * 256 + (n0 & 127) + w3 * 128, scr, lane); continue; }
        r -= 2 * I_UP;
        { const int kb = r / (DM / 32), nb = r % (DM / 32); tr_item(p.f2w2 + oup, DFF, DM, (bf16*)((unsigned char*)wl + OFF_W2B), 64 * kb, 32 * nb, 32 * nb, scr, lane); }
    }
    float* X = p.out; bf16* XG = (bf16*)(p.ws + WS_XG); float* ssq = (float*)(p.ws + WS_SSQ);
    for (int m = gw; m < MROWS; m += NGW) {
        const float* src = m < MP ? p.x_prompt + (size_t)m * DM : p.x_sample + (size_t)(m - MP) * DM;
        float ss = 0.f;
#pragma unroll
        for (int j = 0; j < 4; ++j) {
            const f32x4 v = ((const f32x4*)src)[lane + 64 * j]; const f32x4 g = ((const f32x4*)p.norm_ffn1)[lane + 64 * j];
            ss += (v[0] * v[0] + v[1] * v[1]) + (v[2] * v[2] + v[3] * v[3]);
            ((f32x4*)(X + (size_t)m * DM))[lane + 64 * j] = v;
            u32x2 w; w.x = pk2(v[0] * g[0], v[1] * g[1]); w.y = pk2(v[2] * g[2], v[3] * g[3]);
            ((u32x2*)(XG + (size_t)m * DM))[lane + 64 * j] = w;
        }
        ss = wave_sum(ss);
        if (lane < 16) ssq[(size_t)m * 16 + lane] = lane == 0 ? ss : 0.f;
    }
    if (blockIdx.x == 0 && tid < 64) ((unsigned*)(p.ws + WS_CTR))[tid] = 0u;
}

constexpr int H_QA = 0, H_KA = 17408, H_OF = 0, H_KAT = 34816, H_VT = 53248, H_P = 71680, H_ST = 80896, H_SEG = 115712, H_EREF = 117760, H_DEC = 118272, H_SC = 118784;
constexpr int PQ = 136, PT = 72, POF = 132;
__device__ __forceinline__ void hgrn_seq(LAS unsigned char* lds, const Params& p, int l, int b, int h, bool samp) {
    int tid_ = threadIdx.x; asm volatile("" : "+v"(tid_)); const int tid = tid_, lane = tid & 63, w = tid >> 6, fr = lane & 15, fq = lane >> 4;
    const int c = tid & 127, seg = tid >> 7;
    LAS bf16* QA = (LAS bf16*)(lds + H_QA); LAS bf16* KA = (LAS bf16*)(lds + H_KA); LAS bf16* KAT = (LAS bf16*)(lds + H_KAT); LAS bf16* VT = (LAS bf16*)(lds + H_VT);
    LAS bf16* PP = (LAS bf16*)(lds + H_P); LAS bf16* ST = (LAS bf16*)(lds + H_ST); LAS float* OF = (LAS float*)(lds + H_OF);
    LAS float* SEG = (LAS float*)(lds + H_SEG); LAS float* EREF = (LAS float*)(lds + H_EREF); LAS float* DEC = (LAS float*)(lds + H_DEC); LAS float* SC = (LAS float*)(lds + H_SC);
    const bf16* Z = (const bf16*)(p.ws + WS_Z); bf16* O = (bf16*)(p.ws + WS_O);
    float lbv;
    { const float* lg = p.lb_logits + h * 128 + c; const float a0 = lg[0], a1 = lg[512], a2 = lg[1024], a3 = lg[1536];
      const float mx = fmaxf(fmaxf(a0, a1), fmaxf(a2, a3)); const float e0 = __expf(a0 - mx), e1 = __expf(a1 - mx), e2 = __expf(a2 - mx), e3 = __expf(a3 - mx);
      const float cum = (l >= 1 ? e1 : 0.f) + (l >= 2 ? e2 : 0.f) + (l >= 3 ? e3 : 0.f); lbv = cum / (e0 + e1 + e2 + e3); }
    const size_t sbase = (size_t)((l * 32 + b) * 4 + h) * 16384;
    f32x4 S[8];
#pragma unroll
    for (int kt = 0; kt < 8; ++kt)
#pragma unroll
        for (int r = 0; r < 4; ++r) S[kt][r] = samp ? p.state_in[sbase + (size_t)(kt * 16 + 4 * fq + r) * 128 + w * 16 + fr] : 0.f;
    const int nch = samp ? 1 : 32, rbase = samp ? MP + b * 64 : b * 2048;
    const float* gain = p.hgrn_gain + l * 512 + h * 128;
#pragma unroll 1
    for (int n = 0; n < nch; ++n) {
        const int rowc = rbase + n * 64;
        float bl[16], qv[16], kv[16]; unsigned vv[16];
        float run = 0.f;
        { const bf16* zp = Z + (size_t)(rowc + seg * 16) * DIN + h * 128 + c;
#pragma unroll
          for (int i = 0; i < 16; ++i) {
              const float zq = bf2f(zp[(size_t)i * DIN]), zf = bf2f(zp[(size_t)i * DIN + 512]); vv[i] = zp[(size_t)i * DIN + 1024];
              const float sg = 1.0f / (1.0f + __expf(-zf)); const float f = lbv + (1.0f - lbv) * sg;
              run += __logf(f); bl[i] = run; qv[i] = silu_f(zq) * 0.08838834764831845f; kv[i] = 1.0f - f; } }
        SEG[seg * 128 + c] = run;
        __syncthreads();
        { const float s0 = SEG[c], s1 = SEG[128 + c], s2 = SEG[256 + c], s3 = SEG[384 + c];
          const float pre = (seg > 0 ? s0 : 0.f) + (seg > 1 ? s1 : 0.f) + (seg > 2 ? s2 : 0.f), ref = s0 + s1, tot = ref + s2 + s3;
          unsigned kat[8], vtp[8];
#pragma unroll
          for (int i = 0; i < 16; i += 2) {
              const float b0 = pre + bl[i], b1 = pre + bl[i + 1];
              const float qa0 = qv[i] * __expf(fminf(b0 - ref, 80.f)), qa1 = qv[i + 1] * __expf(fminf(b1 - ref, 80.f));
              const float ka0 = kv[i] * __expf(fminf(ref - b0, 80.f)), ka1 = kv[i + 1] * __expf(fminf(ref - b1, 80.f));
              const unsigned kp = pk2(ka0, ka1), qp = pk2(qa0, qa1);
              QA[(seg * 16 + i) * PQ + c] = (bf16)(qp & 0xffffu); QA[(seg * 16 + i + 1) * PQ + c] = (bf16)(qp >> 16);
              KA[(seg * 16 + i) * PQ + c] = (bf16)(kp & 0xffffu); KA[(seg * 16 + i + 1) * PQ + c] = (bf16)(kp >> 16);
              kat[i >> 1] = kp; vtp[i >> 1] = vv[i] | (vv[i + 1] << 16); }
          *(LAS u32x4*)(KAT + c * PT + seg * 16) = (u32x4){kat[0], kat[1], kat[2], kat[3]}; *(LAS u32x4*)(KAT + c * PT + seg * 16 + 8) = (u32x4){kat[4], kat[5], kat[6], kat[7]};
          *(LAS u32x4*)(VT + c * PT + seg * 16) = (u32x4){vtp[0], vtp[1], vtp[2], vtp[3]}; *(LAS u32x4*)(VT + c * PT + seg * 16 + 8) = (u32x4){vtp[4], vtp[5], vtp[6], vtp[7]};
          if (seg == 0) { EREF[c] = __expf(ref); DEC[c] = __expf(tot); SC[c] = __expf(tot - ref); } }
        __syncthreads();
#pragma unroll
        for (int kt = 0; kt < 8; ++kt) { const int k0 = kt * 16 + 4 * fq; const f32x4 er = *(const LAS f32x4*)(EREF + k0);
            u32x2 wv; wv.x = pk2(S[kt][0] * er[0], S[kt][1] * er[1]); wv.y = pk2(S[kt][2] * er[2], S[kt][3] * er[3]);
            *(LAS u32x2*)(ST + (w * 16 + fr) * PQ + k0) = wv; }
        { const int tt = w >> 1;
#pragma unroll
          for (int j = 0; j < 2; ++j) { const int st = (w & 1) * 2 + j; f32x4 a4 = (f32x4){0.f, 0.f, 0.f, 0.f};
              if (st <= tt) {
#pragma unroll
                  for (int ks = 0; ks < 4; ++ks) { const bf16x8 a = *(const LAS bf16x8*)(KA + (st * 16 + fr) * PQ + ks * 32 + fq * 8); const bf16x8 bb = *(const LAS bf16x8*)(QA + (tt * 16 + fr) * PQ + ks * 32 + fq * 8); a4 = MFMA16(a, bb, a4); } }
              const int t = tt * 16 + fr, s0 = st * 16 + 4 * fq;
              u32x2 wv; wv.x = pk2(s0 + 0 <= t ? a4[0] : 0.f, s0 + 1 <= t ? a4[1] : 0.f); wv.y = pk2(s0 + 2 <= t ? a4[2] : 0.f, s0 + 3 <= t ? a4[3] : 0.f);
              *(LAS u32x2*)(PP + t * PT + s0) = wv; } }
        __syncthreads();
        const int tt = w & 3, vt0 = (w >> 2) * 4;
        f32x4 oacc[4];
#pragma unroll
        for (int j = 0; j < 4; ++j) oacc[j] = (f32x4){0.f, 0.f, 0.f, 0.f};
#pragma unroll
        for (int ks = 0; ks < 4; ++ks) { const bf16x8 bb = *(const LAS bf16x8*)(QA + (tt * 16 + fr) * PQ + ks * 32 + fq * 8);
#pragma unroll
            for (int j = 0; j < 4; ++j) { const bf16x8 a = *(const LAS bf16x8*)(ST + ((vt0 + j) * 16 + fr) * PQ + ks * 32 + fq * 8); oacc[j] = MFMA16(a, bb, oacc[j]); } }
#pragma unroll
        for (int ks = 0; ks < 2; ++ks) { const bf16x8 bb = *(const LAS bf16x8*)(PP + (tt * 16 + fr) * PT + ks * 32 + fq * 8);
#pragma unroll
            for (int j = 0; j < 4; ++j) { const bf16x8 a = *(const LAS bf16x8*)(VT + ((vt0 + j) * 16 + fr) * PT + ks * 32 + fq * 8); oacc[j] = MFMA16(a, bb, oacc[j]); } }
        { f32x4 pacc[8];
#pragma unroll
          for (int kt = 0; kt < 8; ++kt) pacc[kt] = (f32x4){0.f, 0.f, 0.f, 0.f};
#pragma unroll
          for (int ks = 0; ks < 2; ++ks) { const bf16x8 bb = *(const LAS bf16x8*)(VT + (w * 16 + fr) * PT + ks * 32 + fq * 8);
#pragma unroll
              for (int kt = 0; kt < 8; ++kt) { const bf16x8 a = *(const LAS bf16x8*)(KAT + (kt * 16 + fr) * PT + ks * 32 + fq * 8); pacc[kt] = MFMA16(a, bb, pacc[kt]); } }
#pragma unroll
          for (int kt = 0; kt < 8; ++kt) { const int k0 = kt * 16 + 4 * fq; const f32x4 de = *(const LAS f32x4*)(DEC + k0), sc = *(const LAS f32x4*)(SC + k0); S[kt] = de * S[kt] + sc * pacc[kt]; } }
        __syncthreads();
#pragma unroll
        for (int j = 0; j < 4; ++j) *(LAS f32x4*)(OF + (tt * 16 + fr) * POF + (vt0 + j) * 16 + 4 * fq) = oacc[j];
        __syncthreads();
        { const int t = tid >> 3, c0 = (tid & 7) * 16;
          f32x4 ov[4]; float ss = 0.f;
#pragma unroll
          for (int q = 0; q < 4; ++q) { ov[q] = *(const LAS f32x4*)(OF + t * POF + c0 + 4 * q); ss += (ov[q][0] * ov[q][0] + ov[q][1] * ov[q][1]) + (ov[q][2] * ov[q][2] + ov[q][3] * ov[q][3]); }
          ss += __shfl_xor(ss, 1); ss += __shfl_xor(ss, 2); ss += __shfl_xor(ss, 4);
          const float rstd = rsqrtf(ss * (1.0f / 128.0f) + EPS);
          const u32x4* zg = (const u32x4*)(Z + (size_t)(rowc + t) * DIN + 1536 + h * 128 + c0);
          u32x4 outw[2];
#pragma unroll
          for (int hh = 0; hh < 2; ++hh) { const u32x4 zw = zg[hh];
#pragma unroll
              for (int e = 0; e < 4; ++e) { const int ci = hh * 8 + e * 2; const f32x4 gq = *(const f32x4*)(gain + c0 + (ci & ~3));
                  const float o0 = ov[ci >> 2][ci & 3] * rstd * gq[ci & 3] * silu_f(lo_f(zw[e])), o1 = ov[(ci + 1) >> 2][(ci + 1) & 3] * rstd * gq[(ci + 1) & 3] * silu_f(hi_f(zw[e]));
                  outw[hh][e] = pk2(o0, o1); } }
          u32x4* op = (u32x4*)(O + (size_t)(rowc + t) * DM + h * 128 + c0); op[0] = outw[0]; op[1] = outw[1]; }
        __syncthreads();
    }
    float* so = p.out + (samp ? OUT_STS : OUT_STP) + sbase;
#pragma unroll
    for (int kt = 0; kt < 8; ++kt)
#pragma unroll
        for (int r = 0; r < 4; ++r) so[(size_t)(kt * 16 + 4 * fq + r) * 128 + w * 16 + fr] = S[kt][r];
}

constexpr int G_WT = 0, G_VNT = 34816, G_BS = 69632;
__device__ __forceinline__ void sgu_unit(LAS unsigned char* lds, const Params& p, int l, int u) {
    int tid_ = threadIdx.x; asm volatile("" : "+v"(tid_)); const int tid = tid_, lane = tid & 63, w = tid >> 6, fr = lane & 15, fq = lane >> 4;
    const bool samp = u >= 2048; const int us = samp ? u - 2048 : u; const int hs = us & 3, ch = us >> 2;
    const int C = samp ? 64 : 128, row0 = samp ? MP + ch * 64 : ch * 128;
    LAS bf16* WT = (LAS bf16*)(lds + G_WT); LAS bf16* VNT = (LAS bf16*)(lds + G_VNT); LAS float* BS = (LAS float*)(lds + G_BS);
    const bf16* Z = (const bf16*)(p.ws + WS_Z); bf16* O = (bf16*)(p.ws + WS_O);
    const int t4 = tid >> 2, q0 = (tid & 3) * 32;
    if (t4 < C) {
        const float* wsrc = p.sgu_w + (size_t)(l * 4 + hs) * 16384 + t4 * 128 + q0;
#pragma unroll
        for (int q = 0; q < 4; ++q) { const f32x4 a = *(const f32x4*)(wsrc + 8 * q), bq = *(const f32x4*)(wsrc + 8 * q + 4); const int s = q0 + 8 * q;
            u32x4 o; o.x = pk2(s + 0 <= t4 ? a[0] : 0.f, s + 1 <= t4 ? a[1] : 0.f); o.y = pk2(s + 2 <= t4 ? a[2] : 0.f, s + 3 <= t4 ? a[3] : 0.f);
            o.z = pk2(s + 4 <= t4 ? bq[0] : 0.f, s + 5 <= t4 ? bq[1] : 0.f); o.w = pk2(s + 6 <= t4 ? bq[2] : 0.f, s + 7 <= t4 ? bq[3] : 0.f);
            *(LAS u32x4*)(WT + t4 * PQ + s) = o; }
        const u32x4* zv = (const u32x4*)(Z + (size_t)(row0 + t4) * DIN + 2560 + hs * 128 + q0);
        float v[32]; float sm = 0.f;
#pragma unroll
        for (int q = 0; q < 4; ++q) { const u32x4 zw = zv[q];
#pragma unroll
            for (int e = 0; e < 4; ++e) { v[q * 8 + e * 2] = gelu_f(lo_f(zw[e])); v[q * 8 + e * 2 + 1] = gelu_f(hi_f(zw[e])); sm += v[q * 8 + e * 2] + v[q * 8 + e * 2 + 1]; } }
        sm += __shfl_xor(sm, 1); sm += __shfl_xor(sm, 2);
        const float mu = sm * (1.0f / 128.0f); float vs = 0.f;
#pragma unroll
        for (int j = 0; j < 32; ++j) { v[j] -= mu; vs += v[j] * v[j]; }
        vs += __shfl_xor(vs, 1); vs += __shfl_xor(vs, 2);
        const float rstd = rsqrtf(vs * (1.0f / 128.0f) + EPS);
        const float* lg = p.sgu_g + l * 512 + hs * 128 + q0; const float* lb = p.sgu_b + l * 512 + hs * 128 + q0;
        float* vo = p.out + OUT_VS + ((size_t)(l * 32 + ch) * 64 + t4) * 512 + hs * 128 + q0;
#pragma unroll
        for (int q = 0; q < 8; ++q) { const f32x4 g4 = *(const f32x4*)(lg + 4 * q), b4 = *(const f32x4*)(lb + 4 * q); f32x4 r;
#pragma unroll
            for (int e = 0; e < 4; ++e) { r[e] = v[4 * q + e] * rstd * g4[e] + b4[e]; VNT[(q0 + 4 * q + e) * PQ + t4] = (bf16)f2bf(r[e]); }
            if (samp) *(f32x4*)(vo + 4 * q) = r; }
    }
    if (tid < 128) BS[tid] = p.sgu_bs[(l * 4 + hs) * 128 + tid];
    __syncthreads();
    if (w * 16 < C) {
        const int nks = (w >> 1) + 1;
        f32x4 acc[8];
#pragma unroll
        for (int dt = 0; dt < 8; ++dt) acc[dt] = (f32x4){0.f, 0.f, 0.f, 0.f};
#pragma unroll 1
        for (int ks = 0; ks < nks; ++ks) { const bf16x8 bb = *(const LAS bf16x8*)(WT + (w * 16 + fr) * PQ + ks * 32 + fq * 8);
#pragma unroll
            for (int dt = 0; dt < 8; ++dt) { const bf16x8 a = *(const LAS bf16x8*)(VNT + (dt * 16 + fr) * PQ + ks * 32 + fq * 8); acc[dt] = MFMA16(a, bb, acc[dt]); } }
        const int t = w * 16 + fr; const float bias = BS[t];
        const bf16* zu = Z + (size_t)(row0 + t) * DIN + 2048 + hs * 128; bf16* op = O + (size_t)(row0 + t) * DM + 512 + hs * 128;
#pragma unroll
        for (int dt = 0; dt < 8; ++dt) { const int d = dt * 16 + 4 * fq; const u32x2 zw = *(const u32x2*)(zu + d);
            u32x2 o; o.x = pk2(gelu_f(lo_f(zw.x)) * (acc[dt][0] + bias), gelu_f(hi_f(zw.x)) * (acc[dt][1] + bias)); o.y = pk2(gelu_f(lo_f(zw.y)) * (acc[dt][2] + bias), gelu_f(hi_f(zw.y)) * (acc[dt][3] + bias));
            *(u32x2*)(op + d) = o; }
    }
    __syncthreads();
}

__device__ __forceinline__ void mixer_phase(LAS unsigned char* lds, const Params& p, int l) {
    for (int q = blockIdx.x; q < 256; q += gridDim.x) { if (q < 128) hgrn_seq(lds, p, l, q >> 2, q & 3, false); else hgrn_seq(lds, p, l, (q - 128) >> 2, (q - 128) & 3, true); }
    LAS int* slot = (LAS int*)(lds + 147456 - 64);
    unsigned* ctr = (unsigned*)(p.ws + WS_CTR) + l;
    for (;;) {
        __syncthreads();
        if (threadIdx.x == 0) *slot = (int)atomicAdd(ctr, 1u);
        __syncthreads();
        const int u = *slot;
        if (u >= 2048 + 128) break;
        sgu_unit(lds, p, l, u);
    }
}

__device__ __forceinline__ void final_norm_phase(const Params& p) {
    int tid_ = threadIdx.x; asm volatile("" : "+v"(tid_)); const int tid = tid_, lane = tid & 63, wave = tid >> 6;
    const int gw = blockIdx.x * NWAVES + wave, NGW = gridDim.x * NWAVES;
    const float* ssq = (const float*)(p.ws + WS_SSQ) + (size_t)12 * MROWS * 16;
    for (int m = gw; m < MROWS; m += NGW) {
        const float rs = pg8::row_rstd(ssq, m);
        f32x4* xr = (f32x4*)(p.out + (size_t)m * DM);
#pragma unroll
        for (int j = 0; j < 4; ++j) { const f32x4 v = xr[lane + 64 * j]; const f32x4 g = ((const f32x4*)p.final_norm)[lane + 64 * j]; xr[lane + 64 * j] = v * rs * g; }
    }
}

__global__ void __launch_bounds__(NTHREADS, 2) fwd_megakernel(Params p) {
    extern __shared__ __attribute__((aligned(16))) unsigned char lds_raw[];
    LAS unsigned char* lds = (LAS unsigned char*)lds_raw;
    cg::grid_group grid = cg::this_grid();
    const int G = gridDim.x, bid = blockIdx.x;
    float* X = p.out; bf16* XG = (bf16*)(p.ws + WS_XG); bf16* ZB = (bf16*)(p.ws + WS_Z); bf16* OB = (bf16*)(p.ws + WS_O); float* ssq = (float*)(p.ws + WS_SSQ);
    prologue(lds, p);
    grid.sync();
#pragma unroll 1
    for (int l = 0; l < NL; ++l) {
        const unsigned char* wl = p.ws + WS_W + (size_t)l * SZ_WLAYER;
        {
            pg8::Gemm g{XG, (const bf16*)(wl + OFF_W13A), MROWS, 2 * DFF, DM}; pg8::StaticOrder S; S.init(MROWS, 2 * DFF, G, bid);
            pg8::EpiSwiglu E{ZB, DFF, ssq + (size_t)(3 * l) * MROWS * 16};
            pg8::gemm_phase<pg8::EpiSwiglu, pg8::StaticOrder, true, true>(lds, g, S, E);
        }
        grid.sync();
        {
            pg8::Gemm g{ZB, (const bf16*)(wl + OFF_W2A), MROWS, DM, DFF}; pg8::StaticOrder S; S.init(MROWS, DM, G, bid);
            pg8::EpiResid E{X, XG, p.norm_mix + l * DM, ssq + (size_t)(3 * l + 1) * MROWS * 16, 0.5f};
            pg8::gemm_phase<pg8::EpiResid, pg8::StaticOrder, true, true>(lds, g, S, E);
        }
        grid.sync();
        {
            pg8::Gemm g{XG, (const bf16*)(wl + OFF_WIN), MROWS, DIN, DM}; pg8::StaticOrder S; S.init(MROWS, DIN, G, bid);
            pg8::EpiScale E{ZB, DIN, ssq + (size_t)(3 * l + 1) * MROWS * 16};
            pg8::gemm_phase<pg8::EpiScale, pg8::StaticOrder, true, true>(lds, g, S, E);
        }
        grid.sync();
        mixer_phase(lds, p, l);
        grid.sync();
        {
            pg8::Gemm g{OB, (const bf16*)(wl + OFF_WOUT), MROWS, DM, DM}; pg8::StaticOrder S; S.init(MROWS, DM, G, bid);
            pg8::EpiResid E{X, XG, p.norm_ffn2 + l * DM, ssq + (size_t)(3 * l + 2) * MROWS * 16, 1.0f};
            pg8::gemm_phase<pg8::EpiResid, pg8::StaticOrder, true, true>(lds, g, S, E);
        }
        grid.sync();
        {
            pg8::Gemm g{XG, (const bf16*)(wl + OFF_W13B), MROWS, 2 * DFF, DM}; pg8::StaticOrder S; S.init(MROWS, 2 * DFF, G, bid);
            pg8::EpiSwiglu E{ZB, DFF, ssq + (size_t)(3 * l + 2) * MROWS * 16};
            pg8::gemm_phase<pg8::EpiSwiglu, pg8::StaticOrder, true, true>(lds, g, S, E);
        }
        grid.sync();
        {
            pg8::Gemm g{ZB, (const bf16*)(wl + OFF_W2B), MROWS, DM, DFF}; pg8::StaticOrder S; S.init(MROWS, DM, G, bid);
            pg8::EpiResid E{X, XG, l < NL - 1 ? p.norm_ffn1 + (l + 1) * DM : p.final_norm, ssq + (size_t)(3 * l + 3) * MROWS * 16, 0.5f};
            pg8::gemm_phase<pg8::EpiResid, pg8::StaticOrder, true, true>(lds, g, S, E);
        }
        grid.sync();
    }
    final_norm_phase(p);
}

extern "C" void kernel_launch(void* const* d_in, const int* in_sizes, int n_in, void* d_out, int out_size, void* d_ws, size_t ws_size, hipStream_t stream) {
    static int grid = 0;
    if (grid == 0) {
        if (n_in != 21 || ws_size < WS_END) { fprintf(stderr, "kernel_launch: unexpected n_in %d or ws_size %zu (need %zu)\n", n_in, ws_size, (size_t)WS_END); grid = -1; return; }
        if (hipFuncSetAttribute((const void*)fwd_megakernel, hipFuncAttributeMaxDynamicSharedMemorySize, LDS_BYTES) != hipSuccess) { fprintf(stderr, "kernel_launch: hipFuncSetAttribute failed\n"); grid = -1; return; }
        int dev = 0, cus = 0, per_cu = 0;
        hipGetDevice(&dev); hipDeviceGetAttribute(&cus, hipDeviceAttributeMultiprocessorCount, dev);
        hipOccupancyMaxActiveBlocksPerMultiprocessor(&per_cu, (const void*)fwd_megakernel, NTHREADS, LDS_BYTES);
        if (per_cu < 1) { fprintf(stderr, "kernel_launch: occupancy query says %d blocks per CU\n", per_cu); per_cu = 1; }
        (void)hipGetLastError();
        grid = cus;
    }
    if (grid < 0) return;
    Params p{};
    p.x_prompt = (const float*)d_in[0]; p.x_sample = (const float*)d_in[1]; p.state_in = (const float*)d_in[2]; p.lb_logits = (const float*)d_in[3]; p.norm_ffn1 = (const float*)d_in[4];
    p.f1w1 = (const float*)d_in[5]; p.f1w3 = (const float*)d_in[6]; p.f1w2 = (const float*)d_in[7]; p.norm_mix = (const float*)d_in[8]; p.w_in = (const float*)d_in[9];
    p.hgrn_gain = (const float*)d_in[10]; p.sgu_g = (const float*)d_in[11]; p.sgu_b = (const float*)d_in[12]; p.sgu_w = (const float*)d_in[13]; p.sgu_bs = (const float*)d_in[14];
    p.w_out = (const float*)d_in[15]; p.norm_ffn2 = (const float*)d_in[16]; p.f2w1 = (const float*)d_in[17]; p.f2w3 = (const float*)d_in[18]; p.f2w2 = (const float*)d_in[19]; p.final_norm = (const float*)d_in[20];
    p.out = (float*)d_out; p.ws = (unsigned char*)d_ws;
    void* args[] = {&p};
    hipError_t e = hipLaunchCooperativeKernel((const void*)fwd_megakernel, dim3(grid), dim3(NTHREADS), args, LDS_BYTES, stream);
    if (e != hipSuccess) fprintf(stderr, "kernel_launch: cooperative launch failed: %s (grid %d)\n", hipGetErrorString(e), grid);
}
```

```cpp
#include <hip/hip_runtime.h>
#include <hip/hip_cooperative_groups.h>
#include <cstdio>
#include <cstdint>
namespace cg = cooperative_groups;
namespace pg8 {
#define PG8_LAS __attribute__((address_space(3)))
typedef unsigned short bf16_t;
typedef short bf16x8 __attribute__((ext_vector_type(8)));
typedef float f32x4 __attribute__((ext_vector_type(4)));
typedef unsigned u32x4 __attribute__((ext_vector_type(4)));
constexpr int BM = 256, BK = 64, HALF = 128, HTB = HALF * BK * 2  , STAGE_BYTES = 8 * HTB, NXCD = 8, WGM = 8;

__host__ __device__ __forceinline__ int lds_byte(int r, int c) { const int st = (r >> 4) * 2 + (c >> 5), rr = r & 15, cc = c & 31, ob = rr * 64 + cc * 2; return st * 1024 + (ob ^ (((ob >> 9) & 1) << 5)); }
__host__ __device__ __forceinline__ void stage_rc(int b, int& R, int& C) { const int st = b / 1024, sb = b % 1024, swz = sb ^ (((sb >> 9) & 1) << 5); R = (st >> 1) * 16 + swz / 64; C = (st & 1) * 32 + (swz % 64) / 2; }
__host__ __device__ __forceinline__ int perm32(int rho) { const int n = rho >> 4, i = rho & 15; return 8 * (i >> 2) + 4 * n + (i & 3); }

struct Unit { int pm, pn; };
struct Gemm { const bf16_t* A; const bf16_t* Bt; int M, N, K; };

struct StaticOrder {
    int nM, nN, nwg, G, c;
    __host__ __device__ void init(int M, int N, int G_, int c_) { nM = M / BM; nN = N / BM; nwg = nM * nN; G = G_; c = c_; }
    __host__ __device__ bool next(int i, Unit& u) const {
        const long L = (long)i * G + c; if (L >= nwg) return false;
        int wgid = (int)L; { const int q = nwg / NXCD, r = nwg % NXCD, xcd = wgid % NXCD, off = wgid / NXCD; wgid = (xcd < r ? xcd * (q + 1) : r * (q + 1) + (xcd - r) * q) + off; }
        const int nig = WGM * nN, gid = wgid / nig, fm = gid * WGM, gsz = (nM - fm) < WGM ? (nM - fm) : WGM;
        u.pm = fm + ((wgid % nig) % gsz); u.pn = (wgid % nig) / gsz; return true;
    }
    __device__ __forceinline__ void a_ready(const Unit&) const {}
    __device__ __forceinline__ void done(const Unit&) const {}
};
__device__ __forceinline__ unsigned cvt_pk_bf16(float lo, float hi) { unsigned r; asm volatile("v_cvt_pk_bf16_f32 %0, %1, %2" : "=v"(r) : "v"(lo), "v"(hi)); return r; }
typedef unsigned u32x2 __attribute__((ext_vector_type(2)));
constexpr float RMS_EPS = 1e-6f;
__device__ __forceinline__ float silu_f(float x) { return x / (1.0f + __expf(-x)); }

__device__ __forceinline__ float row_rstd(const float* ssq, int row) {
    const f32x4* sp = (const f32x4*)(ssq + (size_t)row * 16); const f32x4 a = (sp[0] + sp[1]) + (sp[2] + sp[3]);
    return rsqrtf(((a[0] + a[1]) + (a[2] + a[3])) * (1.0f / 1024.0f) + RMS_EPS);
}
struct EpiSwiglu {
    static constexpr bool PERM = true, AFTER_DRAIN = false;
    bf16_t* O; int ldc; const float* ssq;
    __device__ __forceinline__ void operator()(const f32x4 (&acc)[2][2][4][2], const Unit& u, int wr, int wc, int fr, int fq) const {
        const int row0 = u.pm * BM + wr * 64 + fr, col0 = u.pn * HALF + wc * 32 + 8 * fq;
#pragma unroll
        for (int ai = 0; ai < 2; ++ai)
#pragma unroll
            for (int m = 0; m < 4; ++m) {
                const int row = row0 + ai * HALF + m * 16;
                const float rs = row_rstd(ssq, row);
                float o[8];
#pragma unroll
                for (int n = 0; n < 2; ++n)
#pragma unroll
                    for (int j = 0; j < 4; ++j) { const float a = acc[ai][0][m][n][j] * rs, b = acc[ai][1][m][n][j] * rs; o[n * 4 + j] = silu_f(a) * b; }
                u32x4 w; w.x = cvt_pk_bf16(o[0], o[1]); w.y = cvt_pk_bf16(o[2], o[3]); w.z = cvt_pk_bf16(o[4], o[5]); w.w = cvt_pk_bf16(o[6], o[7]);
                *(u32x4*)(O + (size_t)row * ldc + col0) = w;
            }
    }
};
struct EpiScale {
    static constexpr bool PERM = true, AFTER_DRAIN = false;
    bf16_t* O; int ldc; const float* ssq;
    __device__ __forceinline__ void operator()(const f32x4 (&acc)[2][2][4][2], const Unit& u, int wr, int wc, int fr, int fq) const {
        const int row0 = u.pm * BM + wr * 64 + fr, col0 = u.pn * BM + wc * 32 + 8 * fq;
#pragma unroll
        for (int ai = 0; ai < 2; ++ai)
#pragma unroll
            for (int m = 0; m < 4; ++m) {
                const int row = row0 + ai * HALF + m * 16;
                const float rs = row_rstd(ssq, row);
#pragma unroll
                for (int bj = 0; bj < 2; ++bj) {
                    const f32x4 v0 = acc[ai][bj][m][0] * rs, v1 = acc[ai][bj][m][1] * rs;
                    u32x4 w; w.x = cvt_pk_bf16(v0[0], v0[1]); w.y = cvt_pk_bf16(v0[2], v0[3]); w.z = cvt_pk_bf16(v1[0], v1[1]); w.w = cvt_pk_bf16(v1[2], v1[3]);
                    *(u32x4*)(O + (size_t)row * ldc + col0 + bj * HALF) = w;
                }
            }
    }
};
struct EpiResid {
    static constexpr bool PERM = false, AFTER_DRAIN = false;
    float* X; bf16_t* XG; const float* g; float* ssq; float scale;
    __device__ __forceinline__ void operator()(const f32x4 (&acc)[2][2][4][2], const Unit& u, int wr, int wc, int fr, int fq) const {
        const int row0 = u.pm * BM + wr * 64 + fr, col0 = u.pn * BM + wc * 32 + 4 * fq;
        f32x4 gv[2][2];
#pragma unroll
        for (int bj = 0; bj < 2; ++bj)
#pragma unroll
            for (int n = 0; n < 2; ++n) gv[bj][n] = *(const f32x4*)(g + col0 + bj * HALF + n * 16);
#pragma unroll
        for (int ai = 0; ai < 2; ++ai)
#pragma unroll
            for (int m = 0; m < 4; ++m) {
                const int row = row0 + ai * HALF + m * 16;
                float* xr = X + (size_t)row * 1024 + col0; bf16_t* gr = XG + (size_t)row * 1024 + col0;
                float ss = 0.f;
#pragma unroll
                for (int bj = 0; bj < 2; ++bj)
#pragma unroll
                    for (int n = 0; n < 2; ++n) {
                        f32x4 x = *(const f32x4*)(xr + bj * HALF + n * 16);
                        x = x + acc[ai][bj][m][n] * scale;
                        *(f32x4*)(xr + bj * HALF + n * 16) = x;
                        ss += (x[0] * x[0] + x[1] * x[1]) + (x[2] * x[2] + x[3] * x[3]);
                        const f32x4 y = x * gv[bj][n];
                        u32x2 w; w.x = cvt_pk_bf16(y[0], y[1]); w.y = cvt_pk_bf16(y[2], y[3]);
                        *(u32x2*)(gr + bj * HALF + n * 16) = w;
                    }
                ss += __shfl_xor(ss, 16); ss += __shfl_xor(ss, 32);
                if (fq == 0) ssq[(size_t)row * 16 + u.pn * 4 + wc] = ss;
            }
    }
};
template <class Epi, class Sched, bool ALIGN_EPI = false, bool SP2 = false>
__device__ __forceinline__ void gemm_phase(PG8_LAS unsigned char* lds, const Gemm g, const Sched& S, const Epi& E) {
    int tid_ = threadIdx.x; asm volatile("" : "+v"(tid_));
    const int tid = tid_, wid = __builtin_amdgcn_readfirstlane(tid >> 6), lane = tid & 63, wr = wid >> 2, wc = wid & 3, fr = lane & 15, fq = lane >> 4;
    const int K = g.K, nt = K / BK;
    unsigned voffA[2], voffB[2];
#pragma unroll
    for (int i = 0; i < 2; ++i) { int R, C; stage_rc(tid * 16 + i * 8192, R, C); const int Rb = Epi::PERM ? ((R & ~31) + perm32(R & 31)) : R;
        voffA[i] = (unsigned)(R * K + C) * 2u; voffB[i] = (unsigned)(Rb * K + C) * 2u; }
    const size_t kstep = (size_t)(BK * 2);
    const size_t hstep = (size_t)HALF * K * 2;
    const size_t tstep = 2 * hstep;
    const unsigned ldsw = (unsigned)wid * 1024u;
    const int aoff = lds_byte(wr * 64 + fr, fq * 8), boff = lds_byte(wc * 32 + fr, fq * 8);
#define PG8_SA(b, h) (((b) * 2 + (h)) * HTB)
#define PG8_SB(b, h) ((4 + (b) * 2 + (h)) * HTB)
#define PG8_STAGE(bufoff, gbase, voff) do { _Pragma("unroll") for (int _i = 0; _i < 2; ++_i) \
        __builtin_amdgcn_global_load_lds((const unsigned*)((const char*)(gbase) + (voff)[_i]), (PG8_LAS unsigned*)(lds + (bufoff) + ldsw + _i * 8192), 16, 0, 0); } while (0)
#define PG8_LDA(dst, b, h) do { _Pragma("unroll") for (int m = 0; m < 4; ++m) _Pragma("unroll") for (int k = 0; k < 2; ++k) dst[m][k] = *(const PG8_LAS bf16x8*)(lds + PG8_SA(b, h) + aoff + m * 2048 + k * 1024); } while (0)
#define PG8_LDB(dst, b, h) do { _Pragma("unroll") for (int n = 0; n < 2; ++n) _Pragma("unroll") for (int k = 0; k < 2; ++k) dst[n][k] = *(const PG8_LAS bf16x8*)(lds + PG8_SB(b, h) + boff + n * 2048 + k * 1024); } while (0)
#define PG8_MMA(ai, bj, At, Bt) do { __builtin_amdgcn_s_setprio(1); _Pragma("unroll") for (int m = 0; m < 4; ++m) _Pragma("unroll") for (int n = 0; n < 2; ++n) _Pragma("unroll") for (int k = 0; k < 2; ++k) \
        acc[ai][bj][m][n] = __builtin_amdgcn_mfma_f32_16x16x32_bf16(Bt[n][k], At[m][k], acc[ai][bj][m][n], 0, 0, 0); __builtin_amdgcn_s_setprio(0); } while (0)
#define PG8_WAIT_V(n) asm volatile("s_waitcnt vmcnt(" #n ")" ::: "memory")
#define PG8_WAIT_L(n) asm volatile("s_waitcnt lgkmcnt(" #n ")" ::: "memory")
#define PG8_BAR __builtin_amdgcn_s_barrier()
#define PG8_SCHED __builtin_amdgcn_sched_barrier(0)
    Unit cur, nxt; int ui = 0;
    if (!S.next(0, cur)) return;
    f32x4 acc[2][2][4][2];
#pragma unroll
    for (int a = 0; a < 2; ++a)
#pragma unroll
        for (int b = 0; b < 2; ++b)
#pragma unroll
            for (int m = 0; m < 4; ++m)
#pragma unroll
                for (int n = 0; n < 2; ++n) acc[a][b][m][n] = (f32x4){0.f, 0.f, 0.f, 0.f};
    bf16x8 At[4][2], B0[2][2], B1[2][2];
    const char* cA = (const char*)g.A + (size_t)cur.pm * tstep; const char* cB = (const char*)g.Bt + (size_t)cur.pn * tstep;
    S.a_ready(cur);
    if constexpr (SP2) {
        PG8_STAGE(PG8_SB(0, 0), cB, voffB); PG8_STAGE(PG8_SB(0, 1), cB + hstep, voffB); PG8_STAGE(PG8_SA(0, 0), cA, voffA); PG8_STAGE(PG8_SA(0, 1), cA + hstep, voffA);
        if (wr == 1) PG8_BAR;
        PG8_WAIT_V(2); PG8_BAR;
        PG8_STAGE(PG8_SB(1, 0), cB + kstep, voffB); PG8_STAGE(PG8_SA(1, 0), cA + kstep, voffA); PG8_STAGE(PG8_SB(1, 1), cB + hstep + kstep, voffB);
        PG8_WAIT_V(6); PG8_BAR;
    } else {
        PG8_STAGE(PG8_SB(0, 0), cB, voffB); PG8_STAGE(PG8_SA(0, 0), cA, voffA); PG8_STAGE(PG8_SB(0, 1), cB + hstep, voffB); PG8_STAGE(PG8_SA(0, 1), cA + hstep, voffA);
        if (wr == 1) PG8_BAR;
        PG8_WAIT_V(4); PG8_BAR;
        PG8_STAGE(PG8_SB(1, 0), cB + kstep, voffB); PG8_STAGE(PG8_SA(1, 0), cA + kstep, voffA); PG8_STAGE(PG8_SB(1, 1), cB + hstep + kstep, voffB);
        PG8_WAIT_V(6); PG8_BAR;
    }
    for (;;) {
        const bool has_next = S.next(ui + 1, nxt);
        const char* nA = has_next ? (const char*)g.A + (size_t)nxt.pm * tstep : cA; const char* nB = has_next ? (const char*)g.Bt + (size_t)nxt.pn * tstep : cB;
        for (int t = 0; t < nt; t += 2) {
            const bool last = (t == nt - 2);
            const char* a1 = cA + (size_t)(t + 1) * kstep;
            const char* a2 = last ? nA : cA + (size_t)(t + 2) * kstep; const char* b2 = last ? nB : cB + (size_t)(t + 2) * kstep;
            const char* a3 = a2 + kstep; const char* b3 = b2 + kstep;
            if (last && has_next) S.a_ready(nxt);
            if constexpr (SP2) {
            PG8_LDB(B0, 0, 0); PG8_LDB(B1, 0, 1); PG8_SCHED; PG8_LDA(At, 0, 0); PG8_STAGE(PG8_SA(1, 1), a1 + hstep, voffA);
            PG8_WAIT_V(8); PG8_WAIT_L(0); PG8_BAR; PG8_MMA(0, 0, At, B0); PG8_MMA(0, 1, At, B1); PG8_BAR; PG8_SCHED;
            PG8_LDA(At, 0, 1); PG8_STAGE(PG8_SB(0, 0), b2, voffB); PG8_STAGE(PG8_SB(0, 1), b2 + hstep, voffB); PG8_STAGE(PG8_SA(0, 0), a2, voffA);
            PG8_WAIT_V(8); PG8_WAIT_L(0); PG8_BAR; PG8_MMA(1, 0, At, B0); PG8_MMA(1, 1, At, B1); PG8_BAR; PG8_SCHED;
            PG8_LDB(B0, 1, 0); PG8_LDB(B1, 1, 1); PG8_SCHED; PG8_LDA(At, 1, 0); PG8_STAGE(PG8_SA(0, 1), a2 + hstep, voffA);
            PG8_WAIT_V(8); PG8_WAIT_L(0); PG8_BAR; PG8_MMA(0, 0, At, B0); PG8_MMA(0, 1, At, B1); PG8_BAR; PG8_SCHED;
            PG8_LDA(At, 1, 1); PG8_STAGE(PG8_SB(1, 0), b3, voffB); PG8_STAGE(PG8_SB(1, 1), b3 + hstep, voffB); PG8_STAGE(PG8_SA(1, 0), a3, voffA);
            PG8_WAIT_V(8); PG8_WAIT_L(0); PG8_BAR; PG8_MMA(1, 0, At, B0); PG8_MMA(1, 1, At, B1); PG8_BAR; PG8_SCHED;
            } else {
            PG8_LDB(B0, 0, 0); PG8_SCHED; PG8_LDA(At, 0, 0); PG8_STAGE(PG8_SA(1, 1), a1 + hstep, voffA);
            PG8_WAIT_L(8); PG8_BAR; PG8_WAIT_L(0); PG8_MMA(0, 0, At, B0); PG8_BAR; PG8_SCHED;
            PG8_LDB(B1, 0, 1); PG8_STAGE(PG8_SB(0, 0), b2, voffB);
            PG8_BAR; PG8_WAIT_L(0); PG8_MMA(0, 1, At, B1); PG8_BAR;
            PG8_LDA(At, 0, 1); PG8_STAGE(PG8_SA(0, 0), a2, voffA);
            PG8_BAR; PG8_WAIT_L(0); PG8_MMA(1, 0, At, B0); PG8_BAR; PG8_SCHED;
            PG8_STAGE(PG8_SB(0, 1), b2 + hstep, voffB);
            PG8_WAIT_V(6); PG8_BAR; PG8_MMA(1, 1, At, B1); PG8_BAR;
            PG8_LDB(B0, 1, 0); PG8_SCHED; PG8_LDA(At, 1, 0); PG8_STAGE(PG8_SA(0, 1), a2 + hstep, voffA);
            PG8_WAIT_L(8); PG8_BAR; PG8_WAIT_L(0); PG8_MMA(0, 0, At, B0); PG8_BAR; PG8_SCHED;
            PG8_LDB(B1, 1, 1); PG8_STAGE(PG8_SB(1, 0), b3, voffB);
            PG8_BAR; PG8_WAIT_L(0); PG8_MMA(0, 1, At, B1); PG8_BAR;
            PG8_LDA(At, 1, 1); PG8_STAGE(PG8_SA(1, 0), a3, voffA);
            PG8_BAR; PG8_WAIT_L(0); PG8_MMA(1, 0, At, B0); PG8_BAR; PG8_SCHED;
            PG8_STAGE(PG8_SB(1, 1), b3 + hstep, voffB);
            PG8_WAIT_V(6); PG8_BAR; PG8_MMA(1, 1, At, B1); PG8_BAR;
            }
        }
        if constexpr (ALIGN_EPI) { if (wr == 0) PG8_BAR; }
        if constexpr (!Epi::AFTER_DRAIN) { E(acc, cur, wr, wc, fr, fq); S.done(cur); }
        if (!has_next) break;
#pragma unroll
        for (int a = 0; a < 2; ++a)
#pragma unroll
            for (int b = 0; b < 2; ++b)
#pragma unroll
                for (int m = 0; m < 4; ++m)
#pragma unroll
                    for (int n = 0; n < 2; ++n) acc[a][b][m][n] = (f32x4){0.f, 0.f, 0.f, 0.f};
        cur = nxt; cA = nA; cB = nB; ++ui;
        if constexpr (ALIGN_EPI) { if (wr == 1) PG8_BAR; }
    }
    PG8_WAIT_V(0);
    if constexpr (!ALIGN_EPI) { if (wr == 0) PG8_BAR; }
    PG8_BAR;
    if constexpr (Epi::AFTER_DRAIN) { E.fused(acc, cur, wr, wc, fr, fq, lds, wid, lane); S.done(cur); }
#undef PG8_SA
#undef PG8_SB
#undef PG8_STAGE
#undef PG8_LDA
#undef PG8_LDB
#undef PG8_MMA
#undef PG8_WAIT_V
#undef PG8_WAIT_L
#undef PG8_BAR
#undef PG8_SCHED
}
}

#define LAS __attribute__((address_space(3)))
typedef unsigned short bf16;
typedef float f32x4 __attribute__((ext_vector_type(4)));
typedef short bf16x8 __attribute__((ext_vector_type(8)));
typedef unsigned u32x4 __attribute__((ext_vector_type(4)));
typedef unsigned u32x2 __attribute__((ext_vector_type(2)));

constexpr int DM = 1024, DFF = 2816, DIN = 3072, NL = 4;
constexpr int MP = 65536, MSMP = 2048, MROWS = MP + MSMP;
constexpr int NTHREADS = 512, NWAVES = 8;
constexpr int LDS_BYTES = 147456;
constexpr float EPS = 1e-6f;
constexpr size_t SZ_W13 = (size_t)2 * DFF * DM * 2, SZ_W2 = (size_t)DM * DFF * 2, SZ_WIN = (size_t)DIN * DM * 2, SZ_WOUT = (size_t)DM * DM * 2;
constexpr size_t OFF_W13A = 0, OFF_W2A = OFF_W13A + SZ_W13, OFF_WIN = OFF_W2A + SZ_W2, OFF_WOUT = OFF_WIN + SZ_WIN, OFF_W13B = OFF_WOUT + SZ_WOUT, OFF_W2B = OFF_W13B + SZ_W13;
constexpr size_t SZ_WLAYER = OFF_W2B + SZ_W2;
constexpr size_t WS_W = 0;
constexpr size_t WS_XG = ((WS_W + NL * SZ_WLAYER + 4095) / 4096) * 4096;
constexpr size_t WS_Z = WS_XG + (size_t)MROWS * DM * 2;
constexpr size_t WS_O = WS_Z + (size_t)MROWS * DIN * 2;
constexpr size_t WS_SSQ = WS_O + (size_t)MROWS * DM * 2;
constexpr size_t WS_CTR = WS_SSQ + (size_t)13 * MROWS * 16 * 4;
constexpr size_t WS_BAR = WS_CTR + 4096;
constexpr size_t WS_END = WS_BAR + 16384;
constexpr size_t OUT_STP = (size_t)MROWS * DM, OUT_STS = OUT_STP + (size_t)NL * 32 * 4 * 128 * 128, OUT_VS = OUT_STS + (size_t)NL * 32 * 4 * 128 * 128;

struct Params {
    const float *x_prompt, *x_sample, *state_in, *lb_logits, *norm_ffn1, *f1w1, *f1w3, *f1w2, *norm_mix, *w_in, *hgrn_gain, *sgu_g, *sgu_b, *sgu_w, *sgu_bs, *w_out, *norm_ffn2, *f2w1, *f2w3, *f2w2, *final_norm;
    float* out; unsigned char* ws;
};

__device__ __forceinline__ float bf2f(bf16 v) { return __uint_as_float(((unsigned)v) << 16); }
__device__ __forceinline__ unsigned f2bf(float f) { unsigned u = __float_as_uint(f); return (u + 0x7fffu + ((u >> 16) & 1u)) >> 16; }
__device__ __forceinline__ unsigned pk2(float lo, float hi) { return pg8::cvt_pk_bf16(lo, hi); }
__device__ __forceinline__ float lo_f(unsigned w) { return __uint_as_float(w << 16); }
__device__ __forceinline__ float hi_f(unsigned w) { return __uint_as_float(w & 0xffff0000u); }
__device__ __forceinline__ float silu_f(float x) { return x / (1.0f + __expf(-x)); }
__device__ __forceinline__ float gelu_f(float x) { const float u = 1.5957691216f * (x + 0.044715f * x * x * x); return x / (1.0f + __expf(-u)); }
__device__ __forceinline__ float wave_sum(float v) {
#pragma unroll
    for (int o = 1; o < 64; o <<= 1) v += __shfl_xor(v, o);
    return v;
}
#define LDS_WAIT() asm volatile("s_waitcnt lgkmcnt(0)" ::: "memory")
#define MFMA16(a, b, c) __builtin_amdgcn_mfma_f32_16x16x32_bf16((a), (b), (c), 0, 0, 0)

#define XB_TMO      128
#define XB_XCNT(j)  (256  + 64 * (j))
#define XB_XSUB(j)  (1280 + 64 * (j))
#define XB_XGEN(j)  (2304 + 64 * (j))
#define XB_TOP      3328
#define XB_TOPGEN   3392
#define XCD_BAR_WORDS 3456
#define XB_SPIN_CAP (1u << 18)

__device__ __forceinline__ unsigned xb_ld(unsigned* p)              { return __hip_atomic_load(p, __ATOMIC_RELAXED, __HIP_MEMORY_SCOPE_AGENT); }
__device__ __forceinline__ unsigned xb_add(unsigned* p, unsigned v) { return __hip_atomic_fetch_add(p, v, __ATOMIC_RELAXED, __HIP_MEMORY_SCOPE_AGENT); }
__device__ __forceinline__ unsigned xb_xcc_id() { return (unsigned)__builtin_amdgcn_s_getreg((3 << 11) | 20) & 0xFu; }
#define XB_SPIN(cond, bar) do { unsigned _sp = 0; while (cond) { __builtin_amdgcn_s_sleep(1); \
    if ((++_sp & 255u) == 0u) { if (xb_ld(&(bar)[XB_TMO])) break; if (_sp > XB_SPIN_CAP) { atomicAdd(&(bar)[XB_TMO], 1u); break; } } } } while (0)

struct XcdBarrier {
    unsigned* bar; unsigned x;
    volatile LAS unsigned* st;
};

__device__ __forceinline__ XcdBarrier xcd_barrier_post(unsigned* bar, volatile LAS unsigned* st) {
    XcdBarrier b; b.bar = bar; b.x = xb_xcc_id(); b.st = st;
    if (threadIdx.x == 0) (void)xb_add(&bar[XB_XCNT(b.x)], 1u);
    return b;
}
__device__ __forceinline__ void xcd_barrier_complete(unsigned* bar, unsigned x, unsigned& nloc, unsigned& nx) {
    const unsigned G = gridDim.x * gridDim.y * gridDim.z;
    unsigned sum, cnt, mine, sp = 0u;
    for (;;) {
        sum = 0u; cnt = 0u; mine = 0u;
#pragma unroll
        for (unsigned j = 0; j < 16; ++j) { const unsigned c = xb_ld(&bar[XB_XCNT(j)]); sum += c; cnt += (c > 0u) ? 1u : 0u; mine = (j == x) ? c : mine; }
        if (sum == G) break;
        __builtin_amdgcn_s_sleep(1);
        if ((++sp & 255u) == 0u) { if (xb_ld(&bar[XB_TMO])) break; if (sp > XB_SPIN_CAP) { atomicAdd(&bar[XB_TMO], 1u); break; } }
    }
    nloc = mine > 0u ? mine : 1u; nx = cnt > 0u ? cnt : 1u;
}

__device__ __forceinline__ void xcd_barrier(const XcdBarrier& b) {
    asm volatile("s_waitcnt vmcnt(0)" ::: "memory");
    __syncthreads();
    if (threadIdx.x == 0) {
        unsigned* bar = b.bar;
        __builtin_amdgcn_s_waitcnt(0);
        unsigned nloc = b.st[0], nx = b.st[1];
        if (nloc == 0u) { xcd_barrier_complete(bar, b.x, nloc, nx); b.st[0] = nloc; b.st[1] = nx; }
        const unsigned old = xb_add(&bar[XB_XSUB(b.x)], 1u);
        const unsigned gen = old / nloc;
        if (old + 1u == (gen + 1u) * nloc) {
            __builtin_amdgcn_fence(__ATOMIC_RELEASE, "agent");
            asm volatile("s_waitcnt vmcnt(0)" ::: "memory");
            const unsigned og = xb_add(&bar[XB_TOP], 1u);
            const unsigned tg = og / nx;
            if (og + 1u == (tg + 1u) * nx) xb_add(&bar[XB_TOPGEN], 1u);
            else XB_SPIN(xb_ld(&bar[XB_TOPGEN]) == tg, bar);
            __builtin_amdgcn_fence(__ATOMIC_ACQUIRE, "agent");
            xb_add(&bar[XB_XGEN(b.x)], 1u);
            asm volatile("s_waitcnt vmcnt(0)" ::: "memory");
        } else {
            XB_SPIN(xb_ld(&bar[XB_XGEN(b.x)]) == gen, bar);
            __builtin_amdgcn_fence(__ATOMIC_ACQUIRE, "agent");
            asm volatile("s_waitcnt vmcnt(0)" ::: "memory");
        }
    }
    __syncthreads();
}

__device__ __forceinline__ void tr_item(const float* W, int K, int N, bf16* WT, int k0, int n0, int drow0, LAS float* scr, int lane) {
#pragma unroll 8
    for (int i = 0; i < 32; ++i) { const int kk = 2 * i + (lane >> 5); scr[kk * 33 + (lane & 31)] = W[(size_t)(k0 + kk) * N + n0 + (lane & 31)]; }
    LDS_WAIT();
    const int c = lane & 7;
#pragma unroll
    for (int j = 0; j < 4; ++j) { const int n = (lane >> 3) + 8 * j; const LAS float* s = scr + (8 * c) * 33 + n;
        u32x4 o; o.x = pk2(s[0 * 33], s[1 * 33]); o.y = pk2(s[2 * 33], s[3 * 33]); o.z = pk2(s[4 * 33], s[5 * 33]); o.w = pk2(s[6 * 33], s[7 * 33]);
        *(u32x4*)(WT + (size_t)(drow0 + n) * K + k0 + 8 * c) = o; }
    LDS_WAIT();
}
__device__ __forceinline__ void prologue(LAS unsigned char* lds, const Params& p) {
    int tid_ = threadIdx.x; asm volatile("" : "+v"(tid_)); const int tid = tid_, lane = tid & 63, wave = tid >> 6;
    const int gw = blockIdx.x * NWAVES + wave, NGW = gridDim.x * NWAVES;
    LAS float* scr = (LAS float*)(lds + wave * 16384);
    constexpr int I_UP = (DM / 64) * (DFF / 32), I_DN = (DFF / 64) * (DM / 32), I_IN = (DM / 64) * (DIN / 32), I_OUT = (DM / 64) * (DM / 32);
    constexpr int I_LAYER = 6 * I_UP + I_IN + I_OUT;
    static_assert(I_UP == I_DN, "item counts");
    for (int it = gw; it < NL * I_LAYER; it += NGW) {
        const int l = it / I_LAYER; int r = it % I_LAYER;
        bf16* wl = (bf16*)(p.ws + WS_W + (size_t)l * SZ_WLAYER);
        const size_t oup = (size_t)l * DM * DFF, oin = (size_t)l * DM * DIN, oout = (size_t)l * DM * DM;
        if (r < 2 * I_UP) {
            const int w3 = r >= I_UP; r -= w3 * I_UP; const int kb = r / (DFF / 32), nb = r % (DFF / 32), n0 = 32 * nb;
            tr_item((w3 ? p.f1w3 : p.f1w1) + oup, DM, DFF, (bf16*)((unsigned char*)wl + OFF_W13A), 64 * kb, n0, (n0 >> 7) * 256 + (n0 & 127) + w3 * 128 - 0, scr, lane); continue; }
        r -= 2 * I_UP;
        if (r < I_DN) { const int kb = r / (DM / 32), nb = r % (DM / 32); tr_item(p.f1w2 + oup, DFF, DM, (bf16*)((unsigned char*)wl + OFF_W2A), 64 * kb, 32 * nb, 32 * nb, scr, lane); continue; }
        r -= I_DN;
        if (r < I_IN) { const int kb = r / (DIN / 32), nb = r % (DIN / 32); tr_item(p.w_in + oin, DM, DIN, (bf16*)((unsigned char*)wl + OFF_WIN), 64 * kb, 32 * nb, 32 * nb, scr, lane); continue; }
        r -= I_IN;
        if (r < I_OUT) { const int kb = r / (DM / 32), nb = r % (DM / 32); tr_item(p.w_out + oout, DM, DM, (bf16*)((unsigned char*)wl + OFF_WOUT), 64 * kb, 32 * nb, 32 * nb, scr, lane); continue; }
        r -= I_OUT;
        if (r < 2 * I_UP) {
            const int w3 = r >= I_UP; r -= w3 * I_UP; const int kb = r / (DFF / 32), nb = r % (DFF / 32), n0 = 32 * nb;
            tr_item((w3 ? p.f2w3 : p.f2w1) + oup, DM, DFF, (bf16*)((unsigned char*)wl + OFF_W13B), 64 * kb, n0, (n0 >> 7) * 256 + (n0 & 127) + w3 * 128, scr, lane); continue; }
        r -= 2 * I_UP;
        { const int kb = r / (DM / 32), nb = r % (DM / 32); tr_item(p.f2w2 + oup, DFF, DM, (bf16*)((unsigned char*)wl + OFF_W2B), 64 * kb, 32 * nb, 32 * nb, scr, lane); }
    }
    float* X = p.out; bf16* XG = (bf16*)(p.ws + WS_XG); float* ssq = (float*)(p.ws + WS_SSQ);
    for (int m = gw; m < MROWS; m += NGW) {
        const float* src = m < MP ? p.x_prompt + (size_t)m * DM : p.x_sample + (size_t)(m - MP) * DM;
        float ss = 0.f;
#pragma unroll
        for (int j = 0; j < 4; ++j) {
            const f32x4 v = ((const f32x4*)src)[lane + 64 * j]; const f32x4 g = ((const f32x4*)p.norm_ffn1)[lane + 64 * j];
            ss += (v[0] * v[0] + v[1] * v[1]) + (v[2] * v[2] + v[3] * v[3]);
            ((f32x4*)(X + (size_t)m * DM))[lane + 64 * j] = v;
            u32x2 w; w.x = pk2(v[0] * g[0], v[1] * g[1]); w.y = pk2(v[2] * g[2], v[3] * g[3]);
            ((u32x2*)(XG + (size_t)m * DM))[lane + 64 * j] = w;
        }
        ss = wave_sum(ss);
        if (lane < 16) ssq[(size_t)m * 16 + lane] = lane == 0 ? ss : 0.f;
    }
    if (blockIdx.x == 0) { if (tid < 64) ((unsigned*)(p.ws + WS_CTR))[tid] = 0u; for (int i = tid; i < XCD_BAR_WORDS; i += NTHREADS) ((unsigned*)(p.ws + WS_BAR))[i] = 0u; }
}

constexpr int H_QA = 0, H_KA = 17408, H_OF = 0, H_KAT = 34816, H_VT = 53248, H_P = 71680, H_ST = 80896, H_SEG = 115712, H_EREF = 117760, H_DEC = 118272, H_SC = 118784;
constexpr int PQ = 136, PT = 72, POF = 132;
__device__ __forceinline__ void hgrn_seq(LAS unsigned char* lds, const Params& p, int l, int b, int h, bool samp) {
    int tid_ = threadIdx.x; asm volatile("" : "+v"(tid_)); const int tid = tid_, lane = tid & 63, w = tid >> 6, fr = lane & 15, fq = lane >> 4;
    const int c = tid & 127, seg = tid >> 7;
    LAS bf16* QA = (LAS bf16*)(lds + H_QA); LAS bf16* KA = (LAS bf16*)(lds + H_KA); LAS bf16* KAT = (LAS bf16*)(lds + H_KAT); LAS bf16* VT = (LAS bf16*)(lds + H_VT);
    LAS bf16* PP = (LAS bf16*)(lds + H_P); LAS bf16* ST = (LAS bf16*)(lds + H_ST); LAS float* OF = (LAS float*)(lds + H_OF);
    LAS float* SEG = (LAS float*)(lds + H_SEG); LAS float* EREF = (LAS float*)(lds + H_EREF); LAS float* DEC = (LAS float*)(lds + H_DEC); LAS float* SC = (LAS float*)(lds + H_SC);
    const bf16* Z = (const bf16*)(p.ws + WS_Z); bf16* O = (bf16*)(p.ws + WS_O);
    float lbv;
    { const float* lg = p.lb_logits + h * 128 + c; const float a0 = lg[0], a1 = lg[512], a2 = lg[1024], a3 = lg[1536];
      const float mx = fmaxf(fmaxf(a0, a1), fmaxf(a2, a3)); const float e0 = __expf(a0 - mx), e1 = __expf(a1 - mx), e2 = __expf(a2 - mx), e3 = __expf(a3 - mx);
      const float cum = (l >= 1 ? e1 : 0.f) + (l >= 2 ? e2 : 0.f) + (l >= 3 ? e3 : 0.f); lbv = cum / (e0 + e1 + e2 + e3); }
    const size_t sbase = (size_t)((l * 32 + b) * 4 + h) * 16384;
    f32x4 S[8];
#pragma unroll
    for (int kt = 0; kt < 8; ++kt)
#pragma unroll
        for (int r = 0; r < 4; ++r) S[kt][r] = samp ? p.state_in[sbase + (size_t)(kt * 16 + 4 * fq + r) * 128 + w * 16 + fr] : 0.f;
    const int nch = samp ? 1 : 32, rbase = samp ? MP + b * 64 : b * 2048;
    const float* gain = p.hgrn_gain + l * 512 + h * 128;
#pragma unroll 1
    for (int n = 0; n < nch; ++n) {
        const int rowc = rbase + n * 64;
        float bl[16], qv[16], kv[16]; unsigned vv[16];
        float run = 0.f;
        { const bf16* zp = Z + (size_t)(rowc + seg * 16) * DIN + h * 128 + c;
#pragma unroll
          for (int i = 0; i < 16; ++i) {
              const float zq = bf2f(zp[(size_t)i * DIN]), zf = bf2f(zp[(size_t)i * DIN + 512]); vv[i] = zp[(size_t)i * DIN + 1024];
              const float sg = 1.0f / (1.0f + __expf(-zf)); const float f = lbv + (1.0f - lbv) * sg;
              run += __logf(f); bl[i] = run; qv[i] = silu_f(zq) * 0.08838834764831845f; kv[i] = 1.0f - f; } }
        SEG[seg * 128 + c] = run;
        __syncthreads();
        { const float s0 = SEG[c], s1 = SEG[128 + c], s2 = SEG[256 + c], s3 = SEG[384 + c];
          const float pre = (seg > 0 ? s0 : 0.f) + (seg > 1 ? s1 : 0.f) + (seg > 2 ? s2 : 0.f), ref = s0 + s1, tot = ref + s2 + s3;
          unsigned kat[8], vtp[8];
#pragma unroll
          for (int i = 0; i < 16; i += 2) {
              const float b0 = pre + bl[i], b1 = pre + bl[i + 1];
              const float qa0 = qv[i] * __expf(fminf(b0 - ref, 80.f)), qa1 = qv[i + 1] * __expf(fminf(b1 - ref, 80.f));
              const float ka0 = kv[i] * __expf(fminf(ref - b0, 80.f)), ka1 = kv[i + 1] * __expf(fminf(ref - b1, 80.f));
              const unsigned kp = pk2(ka0, ka1), qp = pk2(qa0, qa1);
              QA[(seg * 16 + i) * PQ + c] = (bf16)(qp & 0xffffu); QA[(seg * 16 + i + 1) * PQ + c] = (bf16)(qp >> 16);
              KA[(seg * 16 + i) * PQ + c] = (bf16)(kp & 0xffffu); KA[(seg * 16 + i + 1) * PQ + c] = (bf16)(kp >> 16);
              kat[i >> 1] = kp; vtp[i >> 1] = vv[i] | (vv[i + 1] << 16); }
          *(LAS u32x4*)(KAT + c * PT + seg * 16) = (u32x4){kat[0], kat[1], kat[2], kat[3]}; *(LAS u32x4*)(KAT + c * PT + seg * 16 + 8) = (u32x4){kat[4], kat[5], kat[6], kat[7]};
          *(LAS u32x4*)(VT + c * PT + seg * 16) = (u32x4){vtp[0], vtp[1], vtp[2], vtp[3]}; *(LAS u32x4*)(VT + c * PT + seg * 16 + 8) = (u32x4){vtp[4], vtp[5], vtp[6], vtp[7]};
          if (seg == 0) { EREF[c] = __expf(ref); DEC[c] = __expf(tot); SC[c] = __expf(tot - ref); } }
        __syncthreads();
#pragma unroll
        for (int kt = 0; kt < 8; ++kt) { const int k0 = kt * 16 + 4 * fq; const f32x4 er = *(const LAS f32x4*)(EREF + k0);
            u32x2 wv; wv.x = pk2(S[kt][0] * er[0], S[kt][1] * er[1]); wv.y = pk2(S[kt][2] * er[2], S[kt][3] * er[3]);
            *(LAS u32x2*)(ST + (w * 16 + fr) * PQ + k0) = wv; }
        { const int tt = w >> 1;
#pragma unroll
          for (int j = 0; j < 2; ++j) { const int st = (w & 1) * 2 + j; f32x4 a4 = (f32x4){0.f, 0.f, 0.f, 0.f};
              if (st <= tt) {
#pragma unroll
                  for (int ks = 0; ks < 4; ++ks) { const bf16x8 a = *(const LAS bf16x8*)(KA + (st * 16 + fr) * PQ + ks * 32 + fq * 8); const bf16x8 bb = *(const LAS bf16x8*)(QA + (tt * 16 + fr) * PQ + ks * 32 + fq * 8); a4 = MFMA16(a, bb, a4); } }
              const int t = tt * 16 + fr, s0 = st * 16 + 4 * fq;
              u32x2 wv; wv.x = pk2(s0 + 0 <= t ? a4[0] : 0.f, s0 + 1 <= t ? a4[1] : 0.f); wv.y = pk2(s0 + 2 <= t ? a4[2] : 0.f, s0 + 3 <= t ? a4[3] : 0.f);
              *(LAS u32x2*)(PP + t * PT + s0) = wv; } }
        __syncthreads();
        const int tt = w & 3, vt0 = (w >> 2) * 4;
        f32x4 oacc[4];
#pragma unroll
        for (int j = 0; j < 4; ++j) oacc[j] = (f32x4){0.f, 0.f, 0.f, 0.f};
#pragma unroll
        for (int ks = 0; ks < 4; ++ks) { const bf16x8 bb = *(const LAS bf16x8*)(QA + (tt * 16 + fr) * PQ + ks * 32 + fq * 8);
#pragma unroll
            for (int j = 0; j < 4; ++j) { const bf16x8 a = *(const LAS bf16x8*)(ST + ((vt0 + j) * 16 + fr) * PQ + ks * 32 + fq * 8); oacc[j] = MFMA16(a, bb, oacc[j]); } }
#pragma unroll
        for (int ks = 0; ks < 2; ++ks) { const bf16x8 bb = *(const LAS bf16x8*)(PP + (tt * 16 + fr) * PT + ks * 32 + fq * 8);
#pragma unroll
            for (int j = 0; j < 4; ++j) { const bf16x8 a = *(const LAS bf16x8*)(VT + ((vt0 + j) * 16 + fr) * PT + ks * 32 + fq * 8); oacc[j] = MFMA16(a, bb, oacc[j]); } }
        { f32x4 pacc[8];
#pragma unroll
          for (int kt = 0; kt < 8; ++kt) pacc[kt] = (f32x4){0.f, 0.f, 0.f, 0.f};
#pragma unroll
          for (int ks = 0; ks < 2; ++ks) { const bf16x8 bb = *(const LAS bf16x8*)(VT + (w * 16 + fr) * PT + ks * 32 + fq * 8);
#pragma unroll
              for (int kt = 0; kt < 8; ++kt) { const bf16x8 a = *(const LAS bf16x8*)(KAT + (kt * 16 + fr) * PT + ks * 32 + fq * 8); pacc[kt] = MFMA16(a, bb, pacc[kt]); } }
#pragma unroll
          for (int kt = 0; kt < 8; ++kt) { const int k0 = kt * 16 + 4 * fq; const f32x4 de = *(const LAS f32x4*)(DEC + k0), sc = *(const LAS f32x4*)(SC + k0); S[kt] = de * S[kt] + sc * pacc[kt]; } }
        __syncthreads();
#pragma unroll
        for (int j = 0; j < 4; ++j) *(LAS f32x4*)(OF + (tt * 16 + fr) * POF + (vt0 + j) * 16 + 4 * fq) = oacc[j];
        __syncthreads();
        { const int t = tid >> 3, c0 = (tid & 7) * 16;
          f32x4 ov[4]; float ss = 0.f;
#pragma unroll
          for (int q = 0; q < 4; ++q) { ov[q] = *(const LAS f32x4*)(OF + t * POF + c0 + 4 * q); ss += (ov[q][0] * ov[q][0] + ov[q][1] * ov[q][1]) + (ov[q][2] * ov[q][2] + ov[q][3] * ov[q][3]); }
          ss += __shfl_xor(ss, 1); ss += __shfl_xor(ss, 2); ss += __shfl_xor(ss, 4);
          const float rstd = rsqrtf(ss * (1.0f / 128.0f) + EPS);
          const u32x4* zg = (const u32x4*)(Z + (size_t)(rowc + t) * DIN + 1536 + h * 128 + c0);
          u32x4 outw[2];
#pragma unroll
          for (int hh = 0; hh < 2; ++hh) { const u32x4 zw = zg[hh];
#pragma unroll
              for (int e = 0; e < 4; ++e) { const int ci = hh * 8 + e * 2; const f32x4 gq = *(const f32x4*)(gain + c0 + (ci & ~3));
                  const float o0 = ov[ci >> 2][ci & 3] * rstd * gq[ci & 3] * silu_f(lo_f(zw[e])), o1 = ov[(ci + 1) >> 2][(ci + 1) & 3] * rstd * gq[(ci + 1) & 3] * silu_f(hi_f(zw[e]));
                  outw[hh][e] = pk2(o0, o1); } }
          u32x4* op = (u32x4*)(O + (size_t)(rowc + t) * DM + h * 128 + c0); op[0] = outw[0]; op[1] = outw[1]; }
        __syncthreads();
    }
    float* so = p.out + (samp ? OUT_STS : OUT_STP) + sbase;
#pragma unroll
    for (int kt = 0; kt < 8; ++kt)
#pragma unroll
        for (int r = 0; r < 4; ++r) so[(size_t)(kt * 16 + 4 * fq + r) * 128 + w * 16 + fr] = S[kt][r];
}

constexpr int G_WT = 0, G_VNT = 34816, G_BS = 69632;
__device__ __forceinline__ void sgu_unit(LAS unsigned char* lds, const Params& p, int l, int u) {
    int tid_ = threadIdx.x; asm volatile("" : "+v"(tid_)); const int tid = tid_, lane = tid & 63, w = tid >> 6, fr = lane & 15, fq = lane >> 4;
    const bool samp = u >= 2048; const int us = samp ? u - 2048 : u; const int hs = us & 3, ch = us >> 2;
    const int C = samp ? 64 : 128, row0 = samp ? MP + ch * 64 : ch * 128;
    LAS bf16* WT = (LAS bf16*)(lds + G_WT); LAS bf16* VNT = (LAS bf16*)(lds + G_VNT); LAS float* BS = (LAS float*)(lds + G_BS);
    const bf16* Z = (const bf16*)(p.ws + WS_Z); bf16* O = (bf16*)(p.ws + WS_O);
    const int t4 = tid >> 2, q0 = (tid & 3) * 32;
    if (t4 < C) {
        const float* wsrc = p.sgu_w + (size_t)(l * 4 + hs) * 16384 + t4 * 128 + q0;
#pragma unroll
        for (int q = 0; q < 4; ++q) { const f32x4 a = *(const f32x4*)(wsrc + 8 * q), bq = *(const f32x4*)(wsrc + 8 * q + 4); const int s = q0 + 8 * q;
            u32x4 o; o.x = pk2(s + 0 <= t4 ? a[0] : 0.f, s + 1 <= t4 ? a[1] : 0.f); o.y = pk2(s + 2 <= t4 ? a[2] : 0.f, s + 3 <= t4 ? a[3] : 0.f);
            o.z = pk2(s + 4 <= t4 ? bq[0] : 0.f, s + 5 <= t4 ? bq[1] : 0.f); o.w = pk2(s + 6 <= t4 ? bq[2] : 0.f, s + 7 <= t4 ? bq[3] : 0.f);
            *(LAS u32x4*)(WT + t4 * PQ + s) = o; }
        const u32x4* zv = (const u32x4*)(Z + (size_t)(row0 + t4) * DIN + 2560 + hs * 128 + q0);
        float v[32]; float sm = 0.f;
#pragma unroll
        for (int q = 0; q < 4; ++q) { const u32x4 zw = zv[q];
#pragma unroll
            for (int e = 0; e < 4; ++e) { v[q * 8 + e * 2] = gelu_f(lo_f(zw[e])); v[q * 8 + e * 2 + 1] = gelu_f(hi_f(zw[e])); sm += v[q * 8 + e * 2] + v[q * 8 + e * 2 + 1]; } }
        sm += __shfl_xor(sm, 1); sm += __shfl_xor(sm, 2);
        const float mu = sm * (1.0f / 128.0f); float vs = 0.f;
#pragma unroll
        for (int j = 0; j < 32; ++j) { v[j] -= mu; vs += v[j] * v[j]; }
        vs += __shfl_xor(vs, 1); vs += __shfl_xor(vs, 2);
        const float rstd = rsqrtf(vs * (1.0f / 128.0f) + EPS);
        const float* lg = p.sgu_g + l * 512 + hs * 128 + q0; const float* lb = p.sgu_b + l * 512 + hs * 128 + q0;
        float* vo = p.out + OUT_VS + ((size_t)(l * 32 + ch) * 64 + t4) * 512 + hs * 128 + q0;
#pragma unroll
        for (int q = 0; q < 8; ++q) { const f32x4 g4 = *(const f32x4*)(lg + 4 * q), b4 = *(const f32x4*)(lb + 4 * q); f32x4 r;
#pragma unroll
            for (int e = 0; e < 4; ++e) { r[e] = v[4 * q + e] * rstd * g4[e] + b4[e]; VNT[(q0 + 4 * q + e) * PQ + t4] = (bf16)f2bf(r[e]); }
            if (samp) *(f32x4*)(vo + 4 * q) = r; }
    }
    if (tid < 128) BS[tid] = p.sgu_bs[(l * 4 + hs) * 128 + tid];
    __syncthreads();
    if (w * 16 < C) {
        const int nks = (w >> 1) + 1;
        f32x4 acc[8];
#pragma unroll
        for (int dt = 0; dt < 8; ++dt) acc[dt] = (f32x4){0.f, 0.f, 0.f, 0.f};
#pragma unroll 1
        for (int ks = 0; ks < nks; ++ks) { const bf16x8 bb = *(const LAS bf16x8*)(WT + (w * 16 + fr) * PQ + ks * 32 + fq * 8);
#pragma unroll
            for (int dt = 0; dt < 8; ++dt) { const bf16x8 a = *(const LAS bf16x8*)(VNT + (dt * 16 + fr) * PQ + ks * 32 + fq * 8); acc[dt] = MFMA16(a, bb, acc[dt]); } }
        const int t = w * 16 + fr; const float bias = BS[t];
        const bf16* zu = Z + (size_t)(row0 + t) * DIN + 2048 + hs * 128; bf16* op = O + (size_t)(row0 + t) * DM + 512 + hs * 128;
#pragma unroll
        for (int dt = 0; dt < 8; ++dt) { const int d = dt * 16 + 4 * fq; const u32x2 zw = *(const u32x2*)(zu + d);
            u32x2 o; o.x = pk2(gelu_f(lo_f(zw.x)) * (acc[dt][0] + bias), gelu_f(hi_f(zw.x)) * (acc[dt][1] + bias)); o.y = pk2(gelu_f(lo_f(zw.y)) * (acc[dt][2] + bias), gelu_f(hi_f(zw.y)) * (acc[dt][3] + bias));
            *(u32x2*)(op + d) = o; }
    }
    __syncthreads();
}

__device__ __forceinline__ void mixer_phase(LAS unsigned char* lds, const Params& p, int l, int rep = 0) {
    for (int q = blockIdx.x; q < 256; q += gridDim.x) { if (q < 128) hgrn_seq(lds, p, l, q >> 2, q & 3, false); else hgrn_seq(lds, p, l, (q - 128) >> 2, (q - 128) & 3, true); }
    LAS int* slot = (LAS int*)(lds + LDS_BYTES - 256);
    unsigned* ctr = (unsigned*)(p.ws + WS_CTR) + l + 4 * rep;
    for (;;) {
        __syncthreads();
        if (threadIdx.x == 0) *slot = (int)atomicAdd(ctr, 1u);
        __syncthreads();
        const int u = *slot;
        if (u >= 2048 + 128) break;
        sgu_unit(lds, p, l, u);
    }
}

__device__ __forceinline__ void final_norm_phase(const Params& p) {
    int tid_ = threadIdx.x; asm volatile("" : "+v"(tid_)); const int tid = tid_, lane = tid & 63, wave = tid >> 6;
    const int gw = blockIdx.x * NWAVES + wave, NGW = gridDim.x * NWAVES;
    const float* ssq = (const float*)(p.ws + WS_SSQ) + (size_t)12 * MROWS * 16;
    for (int m = gw; m < MROWS; m += NGW) {
        const float rs = pg8::row_rstd(ssq, m);
        f32x4* xr = (f32x4*)(p.out + (size_t)m * DM);
#pragma unroll
        for (int j = 0; j < 4; ++j) { const f32x4 v = xr[lane + 64 * j]; const f32x4 g = ((const f32x4*)p.final_norm)[lane + 64 * j]; xr[lane + 64 * j] = v * rs * g; }
    }
}

__global__ void __launch_bounds__(NTHREADS, 2) fwd_megakernel(Params p) {
    extern __shared__ __attribute__((aligned(16))) unsigned char lds_raw[];
    LAS unsigned char* lds = (LAS unsigned char*)lds_raw;
    cg::grid_group grid = cg::this_grid();
    const int G = gridDim.x, bid = blockIdx.x;
    float* X = p.out; bf16* XG = (bf16*)(p.ws + WS_XG); bf16* ZB = (bf16*)(p.ws + WS_Z); bf16* OB = (bf16*)(p.ws + WS_O); float* ssq = (float*)(p.ws + WS_SSQ);
    volatile LAS unsigned* bst = (volatile LAS unsigned*)(lds + LDS_BYTES - 128);
    if (threadIdx.x == 0) { bst[0] = 0u; bst[1] = 0u; }
    prologue(lds, p);
    grid.sync();
    const XcdBarrier bar = xcd_barrier_post((unsigned*)(p.ws + WS_BAR), bst);
#pragma unroll 1
    for (int l = 0; l < NL; ++l) {
        const unsigned char* wl = p.ws + WS_W + (size_t)l * SZ_WLAYER;
        {
            pg8::Gemm g{XG, (const bf16*)(wl + OFF_W13A), MROWS, 2 * DFF, DM}; pg8::StaticOrder S; S.init(MROWS, 2 * DFF, G, bid);
            pg8::EpiSwiglu E{ZB, DFF, ssq + (size_t)(3 * l) * MROWS * 16};
            pg8::gemm_phase<pg8::EpiSwiglu, pg8::StaticOrder, true, true>(lds, g, S, E);
        }
        xcd_barrier(bar);
        {
            pg8::Gemm g{ZB, (const bf16*)(wl + OFF_W2A), MROWS, DM, DFF}; pg8::StaticOrder S; S.init(MROWS, DM, G, bid);
            pg8::EpiResid E{X, XG, p.norm_mix + l * DM, ssq + (size_t)(3 * l + 1) * MROWS * 16, 0.5f};
            pg8::gemm_phase<pg8::EpiResid, pg8::StaticOrder, true, true>(lds, g, S, E);
        }
        xcd_barrier(bar);
        {
            pg8::Gemm g{XG, (const bf16*)(wl + OFF_WIN), MROWS, DIN, DM}; pg8::StaticOrder S; S.init(MROWS, DIN, G, bid);
            pg8::EpiScale E{ZB, DIN, ssq + (size_t)(3 * l + 1) * MROWS * 16};
            pg8::gemm_phase<pg8::EpiScale, pg8::StaticOrder, true, true>(lds, g, S, E);
        }
        xcd_barrier(bar);
#ifndef MIX_REPEAT
#define MIX_REPEAT 1
#endif
#pragma unroll 1
        for (int rep = 0; rep < MIX_REPEAT; ++rep) { mixer_phase(lds, p, l, rep); xcd_barrier(bar); }
        {
            pg8::Gemm g{OB, (const bf16*)(wl + OFF_WOUT), MROWS, DM, DM}; pg8::StaticOrder S; S.init(MROWS, DM, G, bid);
            pg8::EpiResid E{X, XG, p.norm_ffn2 + l * DM, ssq + (size_t)(3 * l + 2) * MROWS * 16, 1.0f};
            pg8::gemm_phase<pg8::EpiResid, pg8::StaticOrder, true, true>(lds, g, S, E);
        }
        xcd_barrier(bar);
        {
            pg8::Gemm g{XG, (const bf16*)(wl + OFF_W13B), MROWS, 2 * DFF, DM}; pg8::StaticOrder S; S.init(MROWS, 2 * DFF, G, bid);
            pg8::EpiSwiglu E{ZB, DFF, ssq + (size_t)(3 * l + 2) * MROWS * 16};
            pg8::gemm_phase<pg8::EpiSwiglu, pg8::StaticOrder, true, true>(lds, g, S, E);
        }
        xcd_barrier(bar);
        {
            pg8::Gemm g{ZB, (const bf16*)(wl + OFF_W2B), MROWS, DM, DFF}; pg8::StaticOrder S; S.init(MROWS, DM, G, bid);
            pg8::EpiResid E{X, XG, l < NL - 1 ? p.norm_ffn1 + (l + 1) * DM : p.final_norm, ssq + (size_t)(3 * l + 3) * MROWS * 16, 0.5f};
            pg8::gemm_phase<pg8::EpiResid, pg8::StaticOrder, true, true>(lds, g, S, E);
        }
        xcd_barrier(bar);
    }
    final_norm_phase(p);
}

extern "C" void kernel_launch(void* const* d_in, const int* in_sizes, int n_in, void* d_out, int out_size, void* d_ws, size_t ws_size, hipStream_t stream) {
    static int grid = 0;
    if (grid == 0) {
        if (n_in != 21 || ws_size < WS_END) { fprintf(stderr, "kernel_launch: unexpected n_in %d or ws_size %zu (need %zu)\n", n_in, ws_size, (size_t)WS_END); grid = -1; return; }
        if (hipFuncSetAttribute((const void*)fwd_megakernel, hipFuncAttributeMaxDynamicSharedMemorySize, LDS_BYTES) != hipSuccess) { fprintf(stderr, "kernel_launch: hipFuncSetAttribute failed\n"); grid = -1; return; }
        int dev = 0, cus = 0, per_cu = 0;
        hipGetDevice(&dev); hipDeviceGetAttribute(&cus, hipDeviceAttributeMultiprocessorCount, dev);
        hipOccupancyMaxActiveBlocksPerMultiprocessor(&per_cu, (const void*)fwd_megakernel, NTHREADS, LDS_BYTES);
        if (per_cu < 1) { fprintf(stderr, "kernel_launch: occupancy query says %d blocks per CU\n", per_cu); per_cu = 1; }
        (void)hipGetLastError();
        grid = cus;
    }
    if (grid < 0) return;
    Params p{};
    p.x_prompt = (const float*)d_in[0]; p.x_sample = (const float*)d_in[1]; p.state_in = (const float*)d_in[2]; p.lb_logits = (const float*)d_in[3]; p.norm_ffn1 = (const float*)d_in[4];
    p.f1w1 = (const float*)d_in[5]; p.f1w3 = (const float*)d_in[6]; p.f1w2 = (const float*)d_in[7]; p.norm_mix = (const float*)d_in[8]; p.w_in = (const float*)d_in[9];
    p.hgrn_gain = (const float*)d_in[10]; p.sgu_g = (const float*)d_in[11]; p.sgu_b = (const float*)d_in[12]; p.sgu_w = (const float*)d_in[13]; p.sgu_bs = (const float*)d_in[14];
    p.w_out = (const float*)d_in[15]; p.norm_ffn2 = (const float*)d_in[16]; p.f2w1 = (const float*)d_in[17]; p.f2w3 = (const float*)d_in[18]; p.f2w2 = (const float*)d_in[19]; p.final_norm = (const float*)d_in[20];
    p.out = (float*)d_out; p.ws = (unsigned char*)d_ws;
    void* args[] = {&p};
    hipError_t e = hipLaunchCooperativeKernel((const void*)fwd_megakernel, dim3(grid), dim3(NTHREADS), args, LDS_BYTES, stream);
    if (e != hipSuccess) fprintf(stderr, "kernel_launch: cooperative launch failed: %s (grid %d)\n", hipGetErrorString(e), grid);
}
```

```cpp
#include <hip/hip_runtime.h>
#include <hip/hip_cooperative_groups.h>
#include <cstdio>
#include <cstdint>
namespace cg = cooperative_groups;
namespace pg8 {
#define PG8_LAS __attribute__((address_space(3)))
typedef unsigned short bf16_t;
typedef short bf16x8 __attribute__((ext_vector_type(8)));
typedef float f32x4 __attribute__((ext_vector_type(4)));
typedef unsigned u32x4 __attribute__((ext_vector_type(4)));
constexpr int BM = 256, BK = 64, HALF = 128, HTB = HALF * BK * 2  , STAGE_BYTES = 8 * HTB, NXCD = 8, WGM = 8;

__host__ __device__ __forceinline__ int lds_byte(int r, int c) { const int st = (r >> 4) * 2 + (c >> 5), rr = r & 15, cc = c & 31, ob = rr * 64 + cc * 2; return st * 1024 + (ob ^ (((ob >> 9) & 1) << 5)); }
__host__ __device__ __forceinline__ void stage_rc(int b, int& R, int& C) { const int st = b / 1024, sb = b % 1024, swz = sb ^ (((sb >> 9) & 1) << 5); R = (st >> 1) * 16 + swz / 64; C = (st & 1) * 32 + (swz % 64) / 2; }
__host__ __device__ __forceinline__ int perm32(int rho) { const int n = rho >> 4, i = rho & 15; return 8 * (i >> 2) + 4 * n + (i & 3); }

struct Unit { int pm, pn; };
struct Gemm { const bf16_t* A; const bf16_t* Bt; int M, N, K; };

struct StaticOrder {
    int nM, nN, nwg, G, c;
    __host__ __device__ void init(int M, int N, int G_, int c_) { nM = M / BM; nN = N / BM; nwg = nM * nN; G = G_; c = c_; }
    __host__ __device__ bool next(int i, Unit& u) const {
        const long L = (long)i * G + c; if (L >= nwg) return false;
        int wgid = (int)L; { const int q = nwg / NXCD, r = nwg % NXCD, xcd = wgid % NXCD, off = wgid / NXCD; wgid = (xcd < r ? xcd * (q + 1) : r * (q + 1) + (xcd - r) * q) + off; }
        const int nig = WGM * nN, gid = wgid / nig, fm = gid * WGM, gsz = (nM - fm) < WGM ? (nM - fm) : WGM;
        u.pm = fm + ((wgid % nig) % gsz); u.pn = (wgid % nig) / gsz; return true;
    }
    __device__ __forceinline__ void a_ready(const Unit&) const {}
    __device__ __forceinline__ void done(const Unit&) const {}
};
__device__ __forceinline__ unsigned cvt_pk_bf16(float lo, float hi) { unsigned r; asm volatile("v_cvt_pk_bf16_f32 %0, %1, %2" : "=v"(r) : "v"(lo), "v"(hi)); return r; }
typedef unsigned u32x2 __attribute__((ext_vector_type(2)));
constexpr float RMS_EPS = 1e-6f;
__device__ __forceinline__ float silu_f(float x) { return x / (1.0f + __expf(-x)); }

__device__ __forceinline__ float row_rstd(const float* ssq, int row) {
    const f32x4* sp = (const f32x4*)(ssq + (size_t)row * 16); const f32x4 a = (sp[0] + sp[1]) + (sp[2] + sp[3]);
    return rsqrtf(((a[0] + a[1]) + (a[2] + a[3])) * (1.0f / 1024.0f) + RMS_EPS);
}
struct EpiSwiglu {
    static constexpr bool PERM = true, AFTER_DRAIN = false;
    bf16_t* O; int ldc; const float* ssq;
    __device__ __forceinline__ void operator()(const f32x4 (&acc)[2][2][4][2], const Unit& u, int wr, int wc, int fr, int fq) const {
        const int row0 = u.pm * BM + wr * 64 + fr, col0 = u.pn * HALF + wc * 32 + 8 * fq;
#pragma unroll
        for (int ai = 0; ai < 2; ++ai)
#pragma unroll
            for (int m = 0; m < 4; ++m) {
                const int row = row0 + ai * HALF + m * 16;
                const float rs = row_rstd(ssq, row);
                float o[8];
#pragma unroll
                for (int n = 0; n < 2; ++n)
#pragma unroll
                    for (int j = 0; j < 4; ++j) { const float a = acc[ai][0][m][n][j] * rs, b = acc[ai][1][m][n][j] * rs; o[n * 4 + j] = silu_f(a) * b; }
                u32x4 w; w.x = cvt_pk_bf16(o[0], o[1]); w.y = cvt_pk_bf16(o[2], o[3]); w.z = cvt_pk_bf16(o[4], o[5]); w.w = cvt_pk_bf16(o[6], o[7]);
                *(u32x4*)(O + (size_t)row * ldc + col0) = w;
            }
    }
};
struct EpiScale {
    static constexpr bool PERM = true, AFTER_DRAIN = false;
    bf16_t* O; int ldc; const float* ssq;
    __device__ __forceinline__ void operator()(const f32x4 (&acc)[2][2][4][2], const Unit& u, int wr, int wc, int fr, int fq) const {
        const int row0 = u.pm * BM + wr * 64 + fr, col0 = u.pn * BM + wc * 32 + 8 * fq;
#pragma unroll
        for (int ai = 0; ai < 2; ++ai)
#pragma unroll
            for (int m = 0; m < 4; ++m) {
                const int row = row0 + ai * HALF + m * 16;
                const float rs = row_rstd(ssq, row);
#pragma unroll
                for (int bj = 0; bj < 2; ++bj) {
                    const f32x4 v0 = acc[ai][bj][m][0] * rs, v1 = acc[ai][bj][m][1] * rs;
                    u32x4 w; w.x = cvt_pk_bf16(v0[0], v0[1]); w.y = cvt_pk_bf16(v0[2], v0[3]); w.z = cvt_pk_bf16(v1[0], v1[1]); w.w = cvt_pk_bf16(v1[2], v1[3]);
                    *(u32x4*)(O + (size_t)row * ldc + col0 + bj * HALF) = w;
                }
            }
    }
};
struct EpiResid {
    static constexpr bool PERM = false, AFTER_DRAIN = false;
    float* X; bf16_t* XG; const float* g; float* ssq; float scale;
    __device__ __forceinline__ void operator()(const f32x4 (&acc)[2][2][4][2], const Unit& u, int wr, int wc, int fr, int fq) const {
        const int row0 = u.pm * BM + wr * 64 + fr, col0 = u.pn * BM + wc * 32 + 4 * fq;
        f32x4 gv[2][2];
#pragma unroll
        for (int bj = 0; bj < 2; ++bj)
#pragma unroll
            for (int n = 0; n < 2; ++n) gv[bj][n] = *(const f32x4*)(g + col0 + bj * HALF + n * 16);
#pragma unroll
        for (int ai = 0; ai < 2; ++ai)
#pragma unroll
            for (int m = 0; m < 4; ++m) {
                const int row = row0 + ai * HALF + m * 16;
                float* xr = X + (size_t)row * 1024 + col0; bf16_t* gr = XG + (size_t)row * 1024 + col0;
                float ss = 0.f;
#pragma unroll
                for (int bj = 0; bj < 2; ++bj)
#pragma unroll
                    for (int n = 0; n < 2; ++n) {
                        f32x4 x = *(const f32x4*)(xr + bj * HALF + n * 16);
                        x = x + acc[ai][bj][m][n] * scale;
                        *(f32x4*)(xr + bj * HALF + n * 16) = x;
                        ss += (x[0] * x[0] + x[1] * x[1]) + (x[2] * x[2] + x[3] * x[3]);
                        const f32x4 y = x * gv[bj][n];
                        u32x2 w; w.x = cvt_pk_bf16(y[0], y[1]); w.y = cvt_pk_bf16(y[2], y[3]);
                        *(u32x2*)(gr + bj * HALF + n * 16) = w;
                    }
                ss += __shfl_xor(ss, 16); ss += __shfl_xor(ss, 32);
                if (fq == 0) ssq[(size_t)row * 16 + u.pn * 4 + wc] = ss;
            }
    }
};
template <class Epi, class Sched, bool ALIGN_EPI = false, bool SP2 = false>
__device__ __forceinline__ void gemm_phase(PG8_LAS unsigned char* lds, const Gemm g, const Sched& S, const Epi& E) {
    int tid_ = threadIdx.x; asm volatile("" : "+v"(tid_));
    const int tid = tid_, wid = __builtin_amdgcn_readfirstlane(tid >> 6), lane = tid & 63, wr = wid >> 2, wc = wid & 3, fr = lane & 15, fq = lane >> 4;
    const int K = g.K, nt = K / BK;
    unsigned voffA[2], voffB[2];
#pragma unroll
    for (int i = 0; i < 2; ++i) { int R, C; stage_rc(tid * 16 + i * 8192, R, C); const int Rb = Epi::PERM ? ((R & ~31) + perm32(R & 31)) : R;
        voffA[i] = (unsigned)(R * K + C) * 2u; voffB[i] = (unsigned)(Rb * K + C) * 2u; }
    const size_t kstep = (size_t)(BK * 2);
    const size_t hstep = (size_t)HALF * K * 2;
    const size_t tstep = 2 * hstep;
    const unsigned ldsw = (unsigned)wid * 1024u;
    const int aoff = lds_byte(wr * 64 + fr, fq * 8), boff = lds_byte(wc * 32 + fr, fq * 8);
#define PG8_SA(b, h) (((b) * 2 + (h)) * HTB)
#define PG8_SB(b, h) ((4 + (b) * 2 + (h)) * HTB)
#define PG8_STAGE(bufoff, gbase, voff) do { _Pragma("unroll") for (int _i = 0; _i < 2; ++_i) \
        __builtin_amdgcn_global_load_lds((const unsigned*)((const char*)(gbase) + (voff)[_i]), (PG8_LAS unsigned*)(lds + (bufoff) + ldsw + _i * 8192), 16, 0, 0); } while (0)
#define PG8_LDA(dst, b, h) do { _Pragma("unroll") for (int m = 0; m < 4; ++m) _Pragma("unroll") for (int k = 0; k < 2; ++k) dst[m][k] = *(const PG8_LAS bf16x8*)(lds + PG8_SA(b, h) + aoff + m * 2048 + k * 1024); } while (0)
#define PG8_LDB(dst, b, h) do { _Pragma("unroll") for (int n = 0; n < 2; ++n) _Pragma("unroll") for (int k = 0; k < 2; ++k) dst[n][k] = *(const PG8_LAS bf16x8*)(lds + PG8_SB(b, h) + boff + n * 2048 + k * 1024); } while (0)
#define PG8_MMA(ai, bj, At, Bt) do { __builtin_amdgcn_s_setprio(1); _Pragma("unroll") for (int m = 0; m < 4; ++m) _Pragma("unroll") for (int n = 0; n < 2; ++n) _Pragma("unroll") for (int k = 0; k < 2; ++k) \
        acc[ai][bj][m][n] = __builtin_amdgcn_mfma_f32_16x16x32_bf16(Bt[n][k], At[m][k], acc[ai][bj][m][n], 0, 0, 0); __builtin_amdgcn_s_setprio(0); } while (0)
#define PG8_WAIT_V(n) asm volatile("s_waitcnt vmcnt(" #n ")" ::: "memory")
#define PG8_WAIT_L(n) asm volatile("s_waitcnt lgkmcnt(" #n ")" ::: "memory")
#define PG8_BAR __builtin_amdgcn_s_barrier()
#define PG8_SCHED __builtin_amdgcn_sched_barrier(0)
    Unit cur, nxt; int ui = 0;
    if (!S.next(0, cur)) return;
    f32x4 acc[2][2][4][2];
#pragma unroll
    for (int a = 0; a < 2; ++a)
#pragma unroll
        for (int b = 0; b < 2; ++b)
#pragma unroll
            for (int m = 0; m < 4; ++m)
#pragma unroll
                for (int n = 0; n < 2; ++n) acc[a][b][m][n] = (f32x4){0.f, 0.f, 0.f, 0.f};
    bf16x8 At[4][2], B0[2][2], B1[2][2];
    const char* cA = (const char*)g.A + (size_t)cur.pm * tstep; const char* cB = (const char*)g.Bt + (size_t)cur.pn * tstep;
    S.a_ready(cur);
    if constexpr (SP2) {
        PG8_STAGE(PG8_SB(0, 0), cB, voffB); PG8_STAGE(PG8_SB(0, 1), cB + hstep, voffB); PG8_STAGE(PG8_SA(0, 0), cA, voffA); PG8_STAGE(PG8_SA(0, 1), cA + hstep, voffA);
        if (wr == 1) PG8_BAR;
        PG8_WAIT_V(2); PG8_BAR;
        PG8_STAGE(PG8_SB(1, 0), cB + kstep, voffB); PG8_STAGE(PG8_SA(1, 0), cA + kstep, voffA); PG8_STAGE(PG8_SB(1, 1), cB + hstep + kstep, voffB);
        PG8_WAIT_V(6); PG8_BAR;
    } else {
        PG8_STAGE(PG8_SB(0, 0), cB, voffB); PG8_STAGE(PG8_SA(0, 0), cA, voffA); PG8_STAGE(PG8_SB(0, 1), cB + hstep, voffB); PG8_STAGE(PG8_SA(0, 1), cA + hstep, voffA);
        if (wr == 1) PG8_BAR;
        PG8_WAIT_V(4); PG8_BAR;
        PG8_STAGE(PG8_SB(1, 0), cB + kstep, voffB); PG8_STAGE(PG8_SA(1, 0), cA + kstep, voffA); PG8_STAGE(PG8_SB(1, 1), cB + hstep + kstep, voffB);
        PG8_WAIT_V(6); PG8_BAR;
    }
    for (;;) {
        const bool has_next = S.next(ui + 1, nxt);
        const char* nA = has_next ? (const char*)g.A + (size_t)nxt.pm * tstep : cA; const char* nB = has_next ? (const char*)g.Bt + (size_t)nxt.pn * tstep : cB;
        for (int t = 0; t < nt; t += 2) {
            const bool last = (t == nt - 2);
            const char* a1 = cA + (size_t)(t + 1) * kstep;
            const char* a2 = last ? nA : cA + (size_t)(t + 2) * kstep; const char* b2 = last ? nB : cB + (size_t)(t + 2) * kstep;
            const char* a3 = a2 + kstep; const char* b3 = b2 + kstep;
            if (last && has_next) S.a_ready(nxt);
            if constexpr (SP2) {
            PG8_LDB(B0, 0, 0); PG8_LDB(B1, 0, 1); PG8_SCHED; PG8_LDA(At, 0, 0); PG8_STAGE(PG8_SA(1, 1), a1 + hstep, voffA);
            PG8_WAIT_V(8); PG8_WAIT_L(0); PG8_BAR; PG8_MMA(0, 0, At, B0); PG8_MMA(0, 1, At, B1); PG8_BAR; PG8_SCHED;
            PG8_LDA(At, 0, 1); PG8_STAGE(PG8_SB(0, 0), b2, voffB); PG8_STAGE(PG8_SB(0, 1), b2 + hstep, voffB); PG8_STAGE(PG8_SA(0, 0), a2, voffA);
            PG8_WAIT_V(8); PG8_WAIT_L(0); PG8_BAR; PG8_MMA(1, 0, At, B0); PG8_MMA(1, 1, At, B1); PG8_BAR; PG8_SCHED;
            PG8_LDB(B0, 1, 0); PG8_LDB(B1, 1, 1); PG8_SCHED; PG8_LDA(At, 1, 0); PG8_STAGE(PG8_SA(0, 1), a2 + hstep, voffA);
            PG8_WAIT_V(8); PG8_WAIT_L(0); PG8_BAR; PG8_MMA(0, 0, At, B0); PG8_MMA(0, 1, At, B1); PG8_BAR; PG8_SCHED;
            PG8_LDA(At, 1, 1); PG8_STAGE(PG8_SB(1, 0), b3, voffB); PG8_STAGE(PG8_SB(1, 1), b3 + hstep, voffB); PG8_STAGE(PG8_SA(1, 0), a3, voffA);
            PG8_WAIT_V(8); PG8_WAIT_L(0); PG8_BAR; PG8_MMA(1, 0, At, B0); PG8_MMA(1, 1, At, B1); PG8_BAR; PG8_SCHED;
            } else {
            PG8_LDB(B0, 0, 0); PG8_SCHED; PG8_LDA(At, 0, 0); PG8_STAGE(PG8_SA(1, 1), a1 + hstep, voffA);
            PG8_WAIT_L(8); PG8_BAR; PG8_WAIT_L(0); PG8_MMA(0, 0, At, B0); PG8_BAR; PG8_SCHED;
            PG8_LDB(B1, 0, 1); PG8_STAGE(PG8_SB(0, 0), b2, voffB);
            PG8_BAR; PG8_WAIT_L(0); PG8_MMA(0, 1, At, B1); PG8_BAR;
            PG8_LDA(At, 0, 1); PG8_STAGE(PG8_SA(0, 0), a2, voffA);
            PG8_BAR; PG8_WAIT_L(0); PG8_MMA(1, 0, At, B0); PG8_BAR; PG8_SCHED;
            PG8_STAGE(PG8_SB(0, 1), b2 + hstep, voffB);
            PG8_WAIT_V(6); PG8_BAR; PG8_MMA(1, 1, At, B1); PG8_BAR;
            PG8_LDB(B0, 1, 0); PG8_SCHED; PG8_LDA(At, 1, 0); PG8_STAGE(PG8_SA(0, 1), a2 + hstep, voffA);
            PG8_WAIT_L(8); PG8_BAR; PG8_WAIT_L(0); PG8_MMA(0, 0, At, B0); PG8_BAR; PG8_SCHED;
            PG8_LDB(B1, 1, 1); PG8_STAGE(PG8_SB(1, 0), b3, voffB);
            PG8_BAR; PG8_WAIT_L(0); PG8_MMA(0, 1, At, B1); PG8_BAR;
            PG8_LDA(At, 1, 1); PG8_STAGE(PG8_SA(1, 0), a3, voffA);
            PG8_BAR; PG8_WAIT_L(0); PG8_MMA(1, 0, At, B0); PG8_BAR; PG8_SCHED;
            PG8_STAGE(PG8_SB(1, 1), b3 + hstep, voffB);
            PG8_WAIT_V(6); PG8_BAR; PG8_MMA(1, 1, At, B1); PG8_BAR;
            }
        }
        if constexpr (ALIGN_EPI) { if (wr == 0) PG8_BAR; }
        if constexpr (!Epi::AFTER_DRAIN) { E(acc, cur, wr, wc, fr, fq); S.done(cur); }
        if (!has_next) break;
#pragma unroll
        for (int a = 0; a < 2; ++a)
#pragma unroll
            for (int b = 0; b < 2; ++b)
#pragma unroll
                for (int m = 0; m < 4; ++m)
#pragma unroll
                    for (int n = 0; n < 2; ++n) acc[a][b][m][n] = (f32x4){0.f, 0.f, 0.f, 0.f};
        cur = nxt; cA = nA; cB = nB; ++ui;
        if constexpr (ALIGN_EPI) { if (wr == 1) PG8_BAR; }
    }
    PG8_WAIT_V(0);
    if constexpr (!ALIGN_EPI) { if (wr == 0) PG8_BAR; }
    PG8_BAR;
    if constexpr (Epi::AFTER_DRAIN) { E.fused(acc, cur, wr, wc, fr, fq, lds, wid, lane); S.done(cur); }
#undef PG8_SA
#undef PG8_SB
#undef PG8_STAGE
#undef PG8_LDA
#undef PG8_LDB
#undef PG8_MMA
#undef PG8_WAIT_V
#undef PG8_WAIT_L
#undef PG8_BAR
#undef PG8_SCHED
}
}

#define LAS __attribute__((address_space(3)))
typedef unsigned short bf16;
typedef float f32x4 __attribute__((ext_vector_type(4)));
typedef short bf16x8 __attribute__((ext_vector_type(8)));
typedef unsigned u32x4 __attribute__((ext_vector_type(4)));
typedef unsigned u32x2 __attribute__((ext_vector_type(2)));

constexpr int DM = 1024, DFF = 2816, DIN = 3072, NL = 4;
constexpr int MP = 65536, MSMP = 2048, MROWS = MP + MSMP;
constexpr int NTHREADS = 512, NWAVES = 8;
constexpr int LDS_BYTES = 147456;
constexpr float EPS = 1e-6f;
constexpr size_t SZ_W13 = (size_t)2 * DFF * DM * 2, SZ_W2 = (size_t)DM * DFF * 2, SZ_WIN = (size_t)DIN * DM * 2, SZ_WOUT = (size_t)DM * DM * 2;
constexpr size_t OFF_W13A = 0, OFF_W2A = OFF_W13A + SZ_W13, OFF_WIN = OFF_W2A + SZ_W2, OFF_WOUT = OFF_WIN + SZ_WIN, OFF_W13B = OFF_WOUT + SZ_WOUT, OFF_W2B = OFF_W13B + SZ_W13;
constexpr size_t SZ_WLAYER = OFF_W2B + SZ_W2;
constexpr size_t WS_W = 0;
constexpr size_t WS_XG = ((WS_W + NL * SZ_WLAYER + 4095) / 4096) * 4096;
constexpr size_t WS_Z = WS_XG + (size_t)MROWS * DM * 2;
constexpr size_t WS_O = WS_Z + (size_t)MROWS * DIN * 2;
constexpr size_t WS_SSQ = WS_O + (size_t)MROWS * DM * 2;
constexpr size_t WS_CTR = WS_SSQ + (size_t)13 * MROWS * 16 * 4;
constexpr size_t WS_BAR = WS_CTR + 4096;
constexpr size_t WS_END = WS_BAR + 16384;
constexpr size_t OUT_STP = (size_t)MROWS * DM, OUT_STS = OUT_STP + (size_t)NL * 32 * 4 * 128 * 128, OUT_VS = OUT_STS + (size_t)NL * 32 * 4 * 128 * 128;

struct Params {
    const float *x_prompt, *x_sample, *state_in, *lb_logits, *norm_ffn1, *f1w1, *f1w3, *f1w2, *norm_mix, *w_in, *hgrn_gain, *sgu_g, *sgu_b, *sgu_w, *sgu_bs, *w_out, *norm_ffn2, *f2w1, *f2w3, *f2w2, *final_norm;
    float* out; unsigned char* ws;
};

__device__ __forceinline__ float bf2f(bf16 v) { return __uint_as_float(((unsigned)v) << 16); }
__device__ __forceinline__ unsigned f2bf(float f) { unsigned u = __float_as_uint(f); return (u + 0x7fffu + ((u >> 16) & 1u)) >> 16; }
__device__ __forceinline__ unsigned pk2(float lo, float hi) { return pg8::cvt_pk_bf16(lo, hi); }
__device__ __forceinline__ float lo_f(unsigned w) { return __uint_as_float(w << 16); }
__device__ __forceinline__ float hi_f(unsigned w) { return __uint_as_float(w & 0xffff0000u); }
__device__ __forceinline__ float silu_f(float x) { return x / (1.0f + __expf(-x)); }
__device__ __forceinline__ float gelu_f(float x) { const float u = 1.5957691216f * (x + 0.044715f * x * x * x); return x / (1.0f + __expf(-u)); }
__device__ __forceinline__ float wave_sum(float v) {
#pragma unroll
    for (int o = 1; o < 64; o <<= 1) v += __shfl_xor(v, o);
    return v;
}
#define LDS_WAIT() asm volatile("s_waitcnt lgkmcnt(0)" ::: "memory")
#define MFMA16(a, b, c) __builtin_amdgcn_mfma_f32_16x16x32_bf16((a), (b), (c), 0, 0, 0)

#define XB_TMO      128
#define XB_XCNT(j)  (256  + 64 * (j))
#define XB_XSUB(j)  (1280 + 64 * (j))
#define XB_XGEN(j)  (2304 + 64 * (j))
#define XB_TOP      3328
#define XB_TOPGEN   3392
#define XCD_BAR_WORDS 3456
#define XB_SPIN_CAP (1u << 18)

__device__ __forceinline__ unsigned xb_ld(unsigned* p)              { return __hip_atomic_load(p, __ATOMIC_RELAXED, __HIP_MEMORY_SCOPE_AGENT); }
__device__ __forceinline__ unsigned xb_add(unsigned* p, unsigned v) { return __hip_atomic_fetch_add(p, v, __ATOMIC_RELAXED, __HIP_MEMORY_SCOPE_AGENT); }
__device__ __forceinline__ unsigned xb_xcc_id() { return (unsigned)__builtin_amdgcn_s_getreg((3 << 11) | 20) & 0xFu; }
#define XB_SPIN(cond, bar) do { unsigned _sp = 0; while (cond) { __builtin_amdgcn_s_sleep(1); \
    if ((++_sp & 255u) == 0u) { if (xb_ld(&(bar)[XB_TMO])) break; if (_sp > XB_SPIN_CAP) { atomicAdd(&(bar)[XB_TMO], 1u); break; } } } } while (0)

struct XcdBarrier {
    unsigned* bar; unsigned x;
    volatile LAS unsigned* st;
};

__device__ __forceinline__ XcdBarrier xcd_barrier_post(unsigned* bar, volatile LAS unsigned* st) {
    XcdBarrier b; b.bar = bar; b.x = xb_xcc_id(); b.st = st;
    if (threadIdx.x == 0) (void)xb_add(&bar[XB_XCNT(b.x)], 1u);
    return b;
}
__device__ __forceinline__ void xcd_barrier_complete(unsigned* bar, unsigned x, unsigned& nloc, unsigned& nx) {
    const unsigned G = gridDim.x * gridDim.y * gridDim.z;
    unsigned sum, cnt, mine, sp = 0u;
    for (;;) {
        sum = 0u; cnt = 0u; mine = 0u;
#pragma unroll
        for (unsigned j = 0; j < 16; ++j) { const unsigned c = xb_ld(&bar[XB_XCNT(j)]); sum += c; cnt += (c > 0u) ? 1u : 0u; mine = (j == x) ? c : mine; }
        if (sum == G) break;
        __builtin_amdgcn_s_sleep(1);
        if ((++sp & 255u) == 0u) { if (xb_ld(&bar[XB_TMO])) break; if (sp > XB_SPIN_CAP) { atomicAdd(&bar[XB_TMO], 1u); break; } }
    }
    nloc = mine > 0u ? mine : 1u; nx = cnt > 0u ? cnt : 1u;
}

__device__ __forceinline__ void xcd_barrier(const XcdBarrier& b) {
    asm volatile("s_waitcnt vmcnt(0)" ::: "memory");
    __syncthreads();
    if (threadIdx.x == 0) {
        unsigned* bar = b.bar;
        __builtin_amdgcn_s_waitcnt(0);
        unsigned nloc = b.st[0], nx = b.st[1];
        if (nloc == 0u) { xcd_barrier_complete(bar, b.x, nloc, nx); b.st[0] = nloc; b.st[1] = nx; }
        const unsigned old = xb_add(&bar[XB_XSUB(b.x)], 1u);
        const unsigned gen = old / nloc;
        if (old + 1u == (gen + 1u) * nloc) {
            __builtin_amdgcn_fence(__ATOMIC_RELEASE, "agent");
            asm volatile("s_waitcnt vmcnt(0)" ::: "memory");
            const unsigned og = xb_add(&bar[XB_TOP], 1u);
            const unsigned tg = og / nx;
            if (og + 1u == (tg + 1u) * nx) xb_add(&bar[XB_TOPGEN], 1u);
            else XB_SPIN(xb_ld(&bar[XB_TOPGEN]) == tg, bar);
            __builtin_amdgcn_fence(__ATOMIC_ACQUIRE, "agent");
            xb_add(&bar[XB_XGEN(b.x)], 1u);
            asm volatile("s_waitcnt vmcnt(0)" ::: "memory");
        } else {
            XB_SPIN(xb_ld(&bar[XB_XGEN(b.x)]) == gen, bar);
            __builtin_amdgcn_fence(__ATOMIC_ACQUIRE, "agent");
            asm volatile("s_waitcnt vmcnt(0)" ::: "memory");
        }
    }
    __syncthreads();
}

__device__ __forceinline__ void tr_item(const float* W, int K, int N, bf16* WT, int k0, int n0, int drow0, LAS float* scr, int lane) {
#pragma unroll 8
    for (int i = 0; i < 32; ++i) { const int kk = 2 * i + (lane >> 5); scr[kk * 33 + (lane & 31)] = W[(size_t)(k0 + kk) * N + n0 + (lane & 31)]; }
    LDS_WAIT();
    const int c = lane & 7;
#pragma unroll
    for (int j = 0; j < 4; ++j) { const int n = (lane >> 3) + 8 * j; const LAS float* s = scr + (8 * c) * 33 + n;
        u32x4 o; o.x = pk2(s[0 * 33], s[1 * 33]); o.y = pk2(s[2 * 33], s[3 * 33]); o.z = pk2(s[4 * 33], s[5 * 33]); o.w = pk2(s[6 * 33], s[7 * 33]);
        *(u32x4*)(WT + (size_t)(drow0 + n) * K + k0 + 8 * c) = o; }
    LDS_WAIT();
}
__device__ __forceinline__ void prologue(LAS unsigned char* lds, const Params& p) {
    int tid_ = threadIdx.x; asm volatile("" : "+v"(tid_)); const int tid = tid_, lane = tid & 63, wave = tid >> 6;
    const int gw = blockIdx.x * NWAVES + wave, NGW = gridDim.x * NWAVES;
    LAS float* scr = (LAS float*)(lds + wave * 16384);
    constexpr int I_UP = (DM / 64) * (DFF / 32), I_DN = (DFF / 64) * (DM / 32), I_IN = (DM / 64) * (DIN / 32), I_OUT = (DM / 64) * (DM / 32);
    constexpr int I_LAYER = 6 * I_UP + I_IN + I_OUT;
    static_assert(I_UP == I_DN, "item counts");
    for (int it = gw; it < NL * I_LAYER; it += NGW) {
        const int l = it / I_LAYER; int r = it % I_LAYER;
        bf16* wl = (bf16*)(p.ws + WS_W + (size_t)l * SZ_WLAYER);
        const size_t oup = (size_t)l * DM * DFF, oin = (size_t)l * DM * DIN, oout = (size_t)l * DM * DM;
        if (r < 2 * I_UP) {
            const int w3 = r >= I_UP; r -= w3 * I_UP; const int kb = r / (DFF / 32), nb = r % (DFF / 32), n0 = 32 * nb;
            tr_item((w3 ? p.f1w3 : p.f1w1) + oup, DM, DFF, (bf16*)((unsigned char*)wl + OFF_W13A), 64 * kb, n0, (n0 >> 7) * 256 + (n0 & 127) + w3 * 128 - 0, scr, lane); continue; }
        r -= 2 * I_UP;
        if (r < I_DN) { const int kb = r / (DM / 32), nb = r % (DM / 32); tr_item(p.f1w2 + oup, DFF, DM, (bf16*)((unsigned char*)wl + OFF_W2A), 64 * kb, 32 * nb, 32 * nb, scr, lane); continue; }
        r -= I_DN;
        if (r < I_IN) { const int kb = r / (DIN / 32), nb = r % (DIN / 32); tr_item(p.w_in + oin, DM, DIN, (bf16*)((unsigned char*)wl + OFF_WIN), 64 * kb, 32 * nb, 32 * nb, scr, lane); continue; }
        r -= I_IN;
        if (r < I_OUT) { const int kb = r / (DM / 32), nb = r % (DM / 32); tr_item(p.w_out + oout, DM, DM, (bf16*)((unsigned char*)wl + OFF_WOUT), 64 * kb, 32 * nb, 32 * nb, scr, lane); continue; }
        r -= I_OUT;
        if (r < 2 * I_UP) {
            const int w3 = r >= I_UP; r -= w3 * I_UP; const int kb = r / (DFF / 32), nb = r % (DFF / 32), n0 = 32 * nb;
            tr_item((w3 ? p.f2w3 : p.f2w1) + oup, DM, DFF, (bf16*)((unsigned char*)wl + OFF_W13B), 64 * kb, n0, (n0 >> 7) * 256 + (n0 & 127) + w3 * 128, scr, lane); continue; }
        r -= 2 * I_UP;
        { const int kb = r / (DM / 32), nb = r % (DM / 32); tr_item(p.f2w2 + oup, DFF, DM, (bf16*)((unsigned char*)wl + OFF_W2B), 64 * kb, 32 * nb, 32 * nb, scr, lane); }
    }
    float* X = p.out; bf16* XG = (bf16*)(p.ws + WS_XG); float* ssq = (float*)(p.ws + WS_SSQ);
    for (int m = gw; m < MROWS; m += NGW) {
        const float* src = m < MP ? p.x_prompt + (size_t)m * DM : p.x_sample + (size_t)(m - MP) * DM;
        float ss = 0.f;
#pragma unroll
        for (int j = 0; j < 4; ++j) {
            const f32x4 v = ((const f32x4*)src)[lane + 64 * j]; const f32x4 g = ((const f32x4*)p.norm_ffn1)[lane + 64 * j];
            ss += (v[0] * v[0] + v[1] * v[1]) + (v[2] * v[2] + v[3] * v[3]);
            ((f32x4*)(X + (size_t)m * DM))[lane + 64 * j] = v;
            u32x2 w; w.x = pk2(v[0] * g[0], v[1] * g[1]); w.y = pk2(v[2] * g[2], v[3] * g[3]);
            ((u32x2*)(XG + (size_t)m * DM))[lane + 64 * j] = w;
        }
        ss = wave_sum(ss);
        if (lane < 16) ssq[(size_t)m * 16 + lane] = lane == 0 ? ss : 0.f;
    }
    if (blockIdx.x == 0) { if (tid < 64) ((unsigned*)(p.ws + WS_CTR))[tid] = 0u; for (int i = tid; i < XCD_BAR_WORDS; i += NTHREADS) ((unsigned*)(p.ws + WS_BAR))[i] = 0u; }
}

constexpr int H_QA = 0, H_KA = 17408, H_KAT = 34816, H_VT = 53248, H_P = 71680, H_ST = 80896, H_SEG = 115712, H_EREF = 119808, H_DEC = 120320, H_SC = 120832, H_RS = 121344;
constexpr int PQ = 136, PT = 72;
#define WG_BAR() do { asm volatile("s_waitcnt lgkmcnt(0)" ::: "memory"); __builtin_amdgcn_s_barrier(); asm volatile("" ::: "memory"); } while (0)
__device__ __forceinline__ float sigm_f(float x) { return __builtin_amdgcn_rcpf(1.0f + __expf(-x)); }
__device__ __forceinline__ void hgrn_seq(LAS unsigned char* lds, const Params& p, int l, int b, int h, bool samp) {
    int tid_ = threadIdx.x; asm volatile("" : "+v"(tid_)); const int tid = tid_, lane = tid & 63, w = tid >> 6, fr = lane & 15, fq = lane >> 4;
    LAS bf16* QA = (LAS bf16*)(lds + H_QA); LAS bf16* KA = (LAS bf16*)(lds + H_KA); LAS bf16* KAT = (LAS bf16*)(lds + H_KAT); LAS bf16* VT = (LAS bf16*)(lds + H_VT);
    LAS bf16* PP = (LAS bf16*)(lds + H_P); LAS bf16* ST = (LAS bf16*)(lds + H_ST);
    LAS float* SEG = (LAS float*)(lds + H_SEG); LAS float* EREF = (LAS float*)(lds + H_EREF); LAS float* DEC = (LAS float*)(lds + H_DEC); LAS float* SC = (LAS float*)(lds + H_SC); LAS float* RS = (LAS float*)(lds + H_RS);
    const bf16* Z = (const bf16*)(p.ws + WS_Z); bf16* O = (bf16*)(p.ws + WS_O);
    typedef float f32x2 __attribute__((ext_vector_type(2)));
    float lbv0, lbv1;
    { const float* lg = p.lb_logits + h * 128 + 2 * lane; const f32x2 a0 = *(const f32x2*)lg, a1 = *(const f32x2*)(lg + 512), a2 = *(const f32x2*)(lg + 1024), a3 = *(const f32x2*)(lg + 1536);
      { const float mx = fmaxf(fmaxf(a0.x, a1.x), fmaxf(a2.x, a3.x)); const float e0 = __expf(a0.x - mx), e1 = __expf(a1.x - mx), e2 = __expf(a2.x - mx), e3 = __expf(a3.x - mx);
        lbv0 = ((l >= 1 ? e1 : 0.f) + (l >= 2 ? e2 : 0.f) + (l >= 3 ? e3 : 0.f)) / (e0 + e1 + e2 + e3); }
      { const float mx = fmaxf(fmaxf(a0.y, a1.y), fmaxf(a2.y, a3.y)); const float e0 = __expf(a0.y - mx), e1 = __expf(a1.y - mx), e2 = __expf(a2.y - mx), e3 = __expf(a3.y - mx);
        lbv1 = ((l >= 1 ? e1 : 0.f) + (l >= 2 ? e2 : 0.f) + (l >= 3 ? e3 : 0.f)) / (e0 + e1 + e2 + e3); } }
    const size_t sbase = (size_t)((l * 32 + b) * 4 + h) * 16384;
    f32x4 S[8];
#pragma unroll
    for (int kt = 0; kt < 8; ++kt)
#pragma unroll
        for (int r = 0; r < 4; ++r) S[kt][r] = samp ? p.state_in[sbase + (size_t)(kt * 16 + 4 * fq + r) * 128 + w * 16 + fr] : 0.f;
    const int nch = samp ? 1 : 32, rbase = samp ? MP + b * 64 : b * 2048;
    const int tt = w & 3, vt0 = (w >> 2) * 4;
    f32x4 gq[4];
#pragma unroll
    for (int j = 0; j < 4; ++j) gq[j] = *(const f32x4*)(p.hgrn_gain + l * 512 + h * 128 + (vt0 + j) * 16 + 4 * fq);
    unsigned cq[8], cf[8], ci[8];
    { const bf16* zp = Z + (size_t)(rbase + w * 8) * DIN + h * 128 + 2 * lane;
#pragma unroll
      for (int i = 0; i < 8; ++i) { cq[i] = *(const unsigned*)(zp + (size_t)i * DIN); cf[i] = *(const unsigned*)(zp + (size_t)i * DIN + 512); ci[i] = *(const unsigned*)(zp + (size_t)i * DIN + 1024); } }
#pragma unroll 1
    for (int n = 0; n < nch; ++n) {
        const int rowc = rbase + n * 64;
        u32x2 zgp[4];
#pragma unroll
        for (int j = 0; j < 4; ++j) zgp[j] = *(const u32x2*)(Z + (size_t)(rowc + tt * 16 + fr) * DIN + 1536 + h * 128 + (vt0 + j) * 16 + 4 * fq);
        float bl0[8], bl1[8], qv0[8], qv1[8], kv0[8], kv1[8]; unsigned vv[8];
        float run0 = 0.f, run1 = 0.f;
#pragma unroll
        for (int i = 0; i < 8; ++i) {
            const float f0 = lbv0 + (1.0f - lbv0) * sigm_f(lo_f(cf[i])), f1 = lbv1 + (1.0f - lbv1) * sigm_f(hi_f(cf[i]));
            run0 += __logf(f0); run1 += __logf(f1); bl0[i] = run0; bl1[i] = run1; kv0[i] = 1.0f - f0; kv1[i] = 1.0f - f1;
            const float zq0 = lo_f(cq[i]), zq1 = hi_f(cq[i]);
            qv0[i] = zq0 * sigm_f(zq0) * 0.08838834764831845f; qv1[i] = zq1 * sigm_f(zq1) * 0.08838834764831845f; vv[i] = ci[i]; }
        *(LAS f32x2*)(SEG + w * 128 + 2 * lane) = (f32x2){run0, run1};
        if (n + 1 < nch) {
            const bf16* zp = Z + (size_t)(rowc + 64 + w * 8) * DIN + h * 128 + 2 * lane;
#pragma unroll
            for (int i = 0; i < 8; ++i) { cq[i] = *(const unsigned*)(zp + (size_t)i * DIN); cf[i] = *(const unsigned*)(zp + (size_t)i * DIN + 512); ci[i] = *(const unsigned*)(zp + (size_t)i * DIN + 1024); } }
        WG_BAR();
        { float pre0 = 0.f, pre1 = 0.f, ref0 = 0.f, ref1 = 0.f, tot0 = 0.f, tot1 = 0.f;
#pragma unroll
          for (int s = 0; s < 8; ++s) { const f32x2 sv = *(const LAS f32x2*)(SEG + s * 128 + 2 * lane);
              if (s < w) { pre0 += sv.x; pre1 += sv.y; } if (s < 4) { ref0 += sv.x; ref1 += sv.y; } tot0 += sv.x; tot1 += sv.y; }
          unsigned kat0[4], kat1[4], vt0w[4], vt1w[4];
#pragma unroll
          for (int i = 0; i < 8; i += 2) {
              float ka0[2], ka1[2];
#pragma unroll
              for (int e = 0; e < 2; ++e) {
                  const float d0 = pre0 + bl0[i + e] - ref0, d1 = pre1 + bl1[i + e] - ref1;
                  const float qa0 = qv0[i + e] * __expf(fminf(d0, 80.f)), qa1 = qv1[i + e] * __expf(fminf(d1, 80.f));
                  ka0[e] = kv0[i + e] * __expf(fminf(-d0, 80.f)); ka1[e] = kv1[i + e] * __expf(fminf(-d1, 80.f));
                  *(LAS unsigned*)(QA + (w * 8 + i + e) * PQ + 2 * lane) = pk2(qa0, qa1);
                  *(LAS unsigned*)(KA + (w * 8 + i + e) * PQ + 2 * lane) = pk2(ka0[e], ka1[e]); }
              kat0[i >> 1] = pk2(ka0[0], ka0[1]); kat1[i >> 1] = pk2(ka1[0], ka1[1]);
              vt0w[i >> 1] = (vv[i] & 0xffffu) | (vv[i + 1] << 16); vt1w[i >> 1] = (vv[i] >> 16) | (vv[i + 1] & 0xffff0000u); }
          *(LAS u32x4*)(KAT + (2 * lane) * PT + w * 8) = (u32x4){kat0[0], kat0[1], kat0[2], kat0[3]}; *(LAS u32x4*)(KAT + (2 * lane + 1) * PT + w * 8) = (u32x4){kat1[0], kat1[1], kat1[2], kat1[3]};
          *(LAS u32x4*)(VT + (2 * lane) * PT + w * 8) = (u32x4){vt0w[0], vt0w[1], vt0w[2], vt0w[3]}; *(LAS u32x4*)(VT + (2 * lane + 1) * PT + w * 8) = (u32x4){vt1w[0], vt1w[1], vt1w[2], vt1w[3]};
          if (w == 0) { *(LAS f32x2*)(EREF + 2 * lane) = (f32x2){__expf(ref0), __expf(ref1)}; *(LAS f32x2*)(DEC + 2 * lane) = (f32x2){__expf(tot0), __expf(tot1)}; *(LAS f32x2*)(SC + 2 * lane) = (f32x2){__expf(tot0 - ref0), __expf(tot1 - ref1)}; } }
        WG_BAR();
#pragma unroll
        for (int kt = 0; kt < 8; ++kt) { const int k0 = kt * 16 + 4 * fq; const f32x4 er = *(const LAS f32x4*)(EREF + k0);
            u32x2 wv; wv.x = pk2(S[kt][0] * er[0], S[kt][1] * er[1]); wv.y = pk2(S[kt][2] * er[2], S[kt][3] * er[3]);
            *(LAS u32x2*)(ST + (w * 16 + fr) * PQ + k0) = wv; }
        { const int pt = w >> 1;
#pragma unroll
          for (int j = 0; j < 2; ++j) { const int st = (w & 1) * 2 + j; f32x4 a4 = (f32x4){0.f, 0.f, 0.f, 0.f};
              if (st <= pt) {
#pragma unroll
                  for (int ks = 0; ks < 4; ++ks) { const bf16x8 a = *(const LAS bf16x8*)(KA + (st * 16 + fr) * PQ + ks * 32 + fq * 8); const bf16x8 bb = *(const LAS bf16x8*)(QA + (pt * 16 + fr) * PQ + ks * 32 + fq * 8); a4 = MFMA16(a, bb, a4); } }
              const int t = pt * 16 + fr, s0 = st * 16 + 4 * fq;
              u32x2 wv; wv.x = pk2(s0 + 0 <= t ? a4[0] : 0.f, s0 + 1 <= t ? a4[1] : 0.f); wv.y = pk2(s0 + 2 <= t ? a4[2] : 0.f, s0 + 3 <= t ? a4[3] : 0.f);
              *(LAS u32x2*)(PP + t * PT + s0) = wv; } }
        WG_BAR();
        f32x4 oacc[4];
#pragma unroll
        for (int j = 0; j < 4; ++j) oacc[j] = (f32x4){0.f, 0.f, 0.f, 0.f};
#pragma unroll
        for (int ks = 0; ks < 4; ++ks) { const bf16x8 bb = *(const LAS bf16x8*)(QA + (tt * 16 + fr) * PQ + ks * 32 + fq * 8);
#pragma unroll
            for (int j = 0; j < 4; ++j) { const bf16x8 a = *(const LAS bf16x8*)(ST + ((vt0 + j) * 16 + fr) * PQ + ks * 32 + fq * 8); oacc[j] = MFMA16(a, bb, oacc[j]); } }
#pragma unroll
        for (int ks = 0; ks < 2; ++ks) { const bf16x8 bb = *(const LAS bf16x8*)(PP + (tt * 16 + fr) * PT + ks * 32 + fq * 8);
#pragma unroll
            for (int j = 0; j < 4; ++j) { const bf16x8 a = *(const LAS bf16x8*)(VT + ((vt0 + j) * 16 + fr) * PT + ks * 32 + fq * 8); oacc[j] = MFMA16(a, bb, oacc[j]); } }
        { float ss = 0.f;
#pragma unroll
          for (int j = 0; j < 4; ++j) ss += (oacc[j][0] * oacc[j][0] + oacc[j][1] * oacc[j][1]) + (oacc[j][2] * oacc[j][2] + oacc[j][3] * oacc[j][3]);
          ss += __shfl_xor(ss, 16); ss += __shfl_xor(ss, 32);
          if (fq == 0) RS[(w >> 2) * 64 + tt * 16 + fr] = ss; }
        { f32x4 pacc[8];
#pragma unroll
          for (int kt = 0; kt < 8; ++kt) pacc[kt] = (f32x4){0.f, 0.f, 0.f, 0.f};
#pragma unroll
          for (int ks = 0; ks < 2; ++ks) { const bf16x8 bb = *(const LAS bf16x8*)(VT + (w * 16 + fr) * PT + ks * 32 + fq * 8);
#pragma unroll
              for (int kt = 0; kt < 8; ++kt) { const bf16x8 a = *(const LAS bf16x8*)(KAT + (kt * 16 + fr) * PT + ks * 32 + fq * 8); pacc[kt] = MFMA16(a, bb, pacc[kt]); } }
#pragma unroll
          for (int kt = 0; kt < 8; ++kt) { const int k0 = kt * 16 + 4 * fq; const f32x4 de = *(const LAS f32x4*)(DEC + k0), sc = *(const LAS f32x4*)(SC + k0); S[kt] = de * S[kt] + sc * pacc[kt]; } }
        WG_BAR();
        { const int t = tt * 16 + fr; const float rstd = rsqrtf((RS[t] + RS[64 + t]) * (1.0f / 128.0f) + EPS);
          bf16* op = O + (size_t)(rowc + t) * DM + h * 128 + 4 * fq;
#pragma unroll
          for (int j = 0; j < 4; ++j) { const float g0 = lo_f(zgp[j].x), g1 = hi_f(zgp[j].x), g2 = lo_f(zgp[j].y), g3 = hi_f(zgp[j].y);
              u32x2 o; o.x = pk2(oacc[j][0] * rstd * gq[j][0] * (g0 * sigm_f(g0)), oacc[j][1] * rstd * gq[j][1] * (g1 * sigm_f(g1)));
              o.y = pk2(oacc[j][2] * rstd * gq[j][2] * (g2 * sigm_f(g2)), oacc[j][3] * rstd * gq[j][3] * (g3 * sigm_f(g3)));
              *(u32x2*)(op + (vt0 + j) * 16) = o; } }
    }
    WG_BAR();
    float* so = p.out + (samp ? OUT_STS : OUT_STP) + sbase;
#pragma unroll
    for (int kt = 0; kt < 8; ++kt)
#pragma unroll
        for (int r = 0; r < 4; ++r) so[(size_t)(kt * 16 + 4 * fq + r) * 128 + w * 16 + fr] = S[kt][r];
}

constexpr int G_WT = 0, G_VNT = 34816, G_BS = 69632;
__device__ __forceinline__ void sgu_unit(LAS unsigned char* lds, const Params& p, int l, int u) {
    int tid_ = threadIdx.x; asm volatile("" : "+v"(tid_)); const int tid = tid_, lane = tid & 63, w = tid >> 6, fr = lane & 15, fq = lane >> 4;
    const bool samp = u >= 2048; const int us = samp ? u - 2048 : u; const int hs = us & 3, ch = us >> 2;
    const int C = samp ? 64 : 128, row0 = samp ? MP + ch * 64 : ch * 128;
    LAS bf16* WT = (LAS bf16*)(lds + G_WT); LAS bf16* VNT = (LAS bf16*)(lds + G_VNT); LAS float* BS = (LAS float*)(lds + G_BS);
    const bf16* Z = (const bf16*)(p.ws + WS_Z); bf16* O = (bf16*)(p.ws + WS_O);
    const int t4 = tid >> 2, q0 = (tid & 3) * 32;
    if (t4 < C) {
        const float* wsrc = p.sgu_w + (size_t)(l * 4 + hs) * 16384 + t4 * 128 + q0;
#pragma unroll
        for (int q = 0; q < 4; ++q) { const f32x4 a = *(const f32x4*)(wsrc + 8 * q), bq = *(const f32x4*)(wsrc + 8 * q + 4); const int s = q0 + 8 * q;
            u32x4 o; o.x = pk2(s + 0 <= t4 ? a[0] : 0.f, s + 1 <= t4 ? a[1] : 0.f); o.y = pk2(s + 2 <= t4 ? a[2] : 0.f, s + 3 <= t4 ? a[3] : 0.f);
            o.z = pk2(s + 4 <= t4 ? bq[0] : 0.f, s + 5 <= t4 ? bq[1] : 0.f); o.w = pk2(s + 6 <= t4 ? bq[2] : 0.f, s + 7 <= t4 ? bq[3] : 0.f);
            *(LAS u32x4*)(WT + t4 * PQ + s) = o; }
        const u32x4* zv = (const u32x4*)(Z + (size_t)(row0 + t4) * DIN + 2560 + hs * 128 + q0);
        float v[32]; float sm = 0.f;
#pragma unroll
        for (int q = 0; q < 4; ++q) { const u32x4 zw = zv[q];
#pragma unroll
            for (int e = 0; e < 4; ++e) { v[q * 8 + e * 2] = gelu_f(lo_f(zw[e])); v[q * 8 + e * 2 + 1] = gelu_f(hi_f(zw[e])); sm += v[q * 8 + e * 2] + v[q * 8 + e * 2 + 1]; } }
        sm += __shfl_xor(sm, 1); sm += __shfl_xor(sm, 2);
        const float mu = sm * (1.0f / 128.0f); float vs = 0.f;
#pragma unroll
        for (int j = 0; j < 32; ++j) { v[j] -= mu; vs += v[j] * v[j]; }
        vs += __shfl_xor(vs, 1); vs += __shfl_xor(vs, 2);
        const float rstd = rsqrtf(vs * (1.0f / 128.0f) + EPS);
        const float* lg = p.sgu_g + l * 512 + hs * 128 + q0; const float* lb = p.sgu_b + l * 512 + hs * 128 + q0;
        float* vo = p.out + OUT_VS + ((size_t)(l * 32 + ch) * 64 + t4) * 512 + hs * 128 + q0;
#pragma unroll
        for (int q = 0; q < 8; ++q) { const f32x4 g4 = *(const f32x4*)(lg + 4 * q), b4 = *(const f32x4*)(lb + 4 * q); f32x4 r;
#pragma unroll
            for (int e = 0; e < 4; ++e) { r[e] = v[4 * q + e] * rstd * g4[e] + b4[e]; VNT[(q0 + 4 * q + e) * PQ + t4] = (bf16)f2bf(r[e]); }
            if (samp) *(f32x4*)(vo + 4 * q) = r; }
    }
    if (tid < 128) BS[tid] = p.sgu_bs[(l * 4 + hs) * 128 + tid];
    __syncthreads();
    if (w * 16 < C) {
        const int nks = (w >> 1) + 1;
        f32x4 acc[8];
#pragma unroll
        for (int dt = 0; dt < 8; ++dt) acc[dt] = (f32x4){0.f, 0.f, 0.f, 0.f};
#pragma unroll 1
        for (int ks = 0; ks < nks; ++ks) { const bf16x8 bb = *(const LAS bf16x8*)(WT + (w * 16 + fr) * PQ + ks * 32 + fq * 8);
#pragma unroll
            for (int dt = 0; dt < 8; ++dt) { const bf16x8 a = *(const LAS bf16x8*)(VNT + (dt * 16 + fr) * PQ + ks * 32 + fq * 8); acc[dt] = MFMA16(a, bb, acc[dt]); } }
        const int t = w * 16 + fr; const float bias = BS[t];
        const bf16* zu = Z + (size_t)(row0 + t) * DIN + 2048 + hs * 128; bf16* op = O + (size_t)(row0 + t) * DM + 512 + hs * 128;
#pragma unroll
        for (int dt = 0; dt < 8; ++dt) { const int d = dt * 16 + 4 * fq; const u32x2 zw = *(const u32x2*)(zu + d);
            u32x2 o; o.x = pk2(gelu_f(lo_f(zw.x)) * (acc[dt][0] + bias), gelu_f(hi_f(zw.x)) * (acc[dt][1] + bias)); o.y = pk2(gelu_f(lo_f(zw.y)) * (acc[dt][2] + bias), gelu_f(hi_f(zw.y)) * (acc[dt][3] + bias));
            *(u32x2*)(op + d) = o; }
    }
    __syncthreads();
}

__device__ __forceinline__ void mixer_phase(LAS unsigned char* lds, const Params& p, int l, int rep = 0) {
    for (int q = blockIdx.x; q < 256; q += gridDim.x) { if (q < 128) hgrn_seq(lds, p, l, q >> 2, q & 3, false); else hgrn_seq(lds, p, l, (q - 128) >> 2, (q - 128) & 3, true); }
    LAS int* slot = (LAS int*)(lds + LDS_BYTES - 256);
    unsigned* ctr = (unsigned*)(p.ws + WS_CTR) + l + 4 * rep;
    for (;;) {
        __syncthreads();
        if (threadIdx.x == 0) *slot = (int)atomicAdd(ctr, 1u);
        __syncthreads();
        const int u = *slot;
        if (u >= 2048 + 128) break;
        sgu_unit(lds, p, l, u);
    }
}

__device__ __forceinline__ void final_norm_phase(const Params& p) {
    int tid_ = threadIdx.x; asm volatile("" : "+v"(tid_)); const int tid = tid_, lane = tid & 63, wave = tid >> 6;
    const int gw = blockIdx.x * NWAVES + wave, NGW = gridDim.x * NWAVES;
    const float* ssq = (const float*)(p.ws + WS_SSQ) + (size_t)12 * MROWS * 16;
    for (int m = gw; m < MROWS; m += NGW) {
        const float rs = pg8::row_rstd(ssq, m);
        f32x4* xr = (f32x4*)(p.out + (size_t)m * DM);
#pragma unroll
        for (int j = 0; j < 4; ++j) { const f32x4 v = xr[lane + 64 * j]; const f32x4 g = ((const f32x4*)p.final_norm)[lane + 64 * j]; xr[lane + 64 * j] = v * rs * g; }
    }
}

__global__ void __launch_bounds__(NTHREADS, 2) fwd_megakernel(Params p) {
    extern __shared__ __attribute__((aligned(16))) unsigned char lds_raw[];
    LAS unsigned char* lds = (LAS unsigned char*)lds_raw;
    cg::grid_group grid = cg::this_grid();
    const int G = gridDim.x, bid = blockIdx.x;
    float* X = p.out; bf16* XG = (bf16*)(p.ws + WS_XG); bf16* ZB = (bf16*)(p.ws + WS_Z); bf16* OB = (bf16*)(p.ws + WS_O); float* ssq = (float*)(p.ws + WS_SSQ);
    volatile LAS unsigned* bst = (volatile LAS unsigned*)(lds + LDS_BYTES - 128);
    if (threadIdx.x == 0) { bst[0] = 0u; bst[1] = 0u; }
    prologue(lds, p);
    grid.sync();
    const XcdBarrier bar = xcd_barrier_post((unsigned*)(p.ws + WS_BAR), bst);
#pragma unroll 1
    for (int l = 0; l < NL; ++l) {
        const unsigned char* wl = p.ws + WS_W + (size_t)l * SZ_WLAYER;
        {
            pg8::Gemm g{XG, (const bf16*)(wl + OFF_W13A), MROWS, 2 * DFF, DM}; pg8::StaticOrder S; S.init(MROWS, 2 * DFF, G, bid);
            pg8::EpiSwiglu E{ZB, DFF, ssq + (size_t)(3 * l) * MROWS * 16};
            pg8::gemm_phase<pg8::EpiSwiglu, pg8::StaticOrder, true, true>(lds, g, S, E);
        }
        xcd_barrier(bar);
        {
            pg8::Gemm g{ZB, (const bf16*)(wl + OFF_W2A), MROWS, DM, DFF}; pg8::StaticOrder S; S.init(MROWS, DM, G, bid);
            pg8::EpiResid E{X, XG, p.norm_mix + l * DM, ssq + (size_t)(3 * l + 1) * MROWS * 16, 0.5f};
            pg8::gemm_phase<pg8::EpiResid, pg8::StaticOrder, true, true>(lds, g, S, E);
        }
        xcd_barrier(bar);
        {
            pg8::Gemm g{XG, (const bf16*)(wl + OFF_WIN), MROWS, DIN, DM}; pg8::StaticOrder S; S.init(MROWS, DIN, G, bid);
            pg8::EpiScale E{ZB, DIN, ssq + (size_t)(3 * l + 1) * MROWS * 16};
            pg8::gemm_phase<pg8::EpiScale, pg8::StaticOrder, true, true>(lds, g, S, E);
        }
        xcd_barrier(bar);
#ifndef MIX_REPEAT
#define MIX_REPEAT 1
#endif
#pragma unroll 1
        for (int rep = 0; rep < MIX_REPEAT; ++rep) { mixer_phase(lds, p, l, rep); xcd_barrier(bar); }
        {
            pg8::Gemm g{OB, (const bf16*)(wl + OFF_WOUT), MROWS, DM, DM}; pg8::StaticOrder S; S.init(MROWS, DM, G, bid);
            pg8::EpiResid E{X, XG, p.norm_ffn2 + l * DM, ssq + (size_t)(3 * l + 2) * MROWS * 16, 1.0f};
            pg8::gemm_phase<pg8::EpiResid, pg8::StaticOrder, true, true>(lds, g, S, E);
        }
        xcd_barrier(bar);
        {
            pg8::Gemm g{XG, (const bf16*)(wl + OFF_W13B), MROWS, 2 * DFF, DM}; pg8::StaticOrder S; S.init(MROWS, 2 * DFF, G, bid);
            pg8::EpiSwiglu E{ZB, DFF, ssq + (size_t)(3 * l + 2) * MROWS * 16};
            pg8::gemm_phase<pg8::EpiSwiglu, pg8::StaticOrder, true, true>(lds, g, S, E);
        }
        xcd_barrier(bar);
        {
            pg8::Gemm g{ZB, (const bf16*)(wl + OFF_W2B), MROWS, DM, DFF}; pg8::StaticOrder S; S.init(MROWS, DM, G, bid);
            pg8::EpiResid E{X, XG, l < NL - 1 ? p.norm_ffn1 + (l + 1) * DM : p.final_norm, ssq + (size_t)(3 * l + 3) * MROWS * 16, 0.5f};
            pg8::gemm_phase<pg8::EpiResid, pg8::StaticOrder, true, true>(lds, g, S, E);
        }
        xcd_barrier(bar);
    }
    final_norm_phase(p);
}

extern "C" void kernel_launch(void* const* d_in, const int* in_sizes, int n_in, void* d_out, int out_size, void* d_ws, size_t ws_size, hipStream_t stream) {
    static int grid = 0;
    if (grid == 0) {
        if (n_in != 21 || ws_size < WS_END) { fprintf(stderr, "kernel_launch: unexpected n_in %d or ws_size %zu (need %zu)\n", n_in, ws_size, (size_t)WS_END); grid = -1; return; }
        if (hipFuncSetAttribute((const void*)fwd_megakernel, hipFuncAttributeMaxDynamicSharedMemorySize, LDS_BYTES) != hipSuccess) { fprintf(stderr, "kernel_launch: hipFuncSetAttribute failed\n"); grid = -1; return; }
        int dev = 0, cus = 0, per_cu = 0;
        hipGetDevice(&dev); hipDeviceGetAttribute(&cus, hipDeviceAttributeMultiprocessorCount, dev);
        hipOccupancyMaxActiveBlocksPerMultiprocessor(&per_cu, (const void*)fwd_megakernel, NTHREADS, LDS_BYTES);
        if (per_cu < 1) { fprintf(stderr, "kernel_launch: occupancy query says %d blocks per CU\n", per_cu); per_cu = 1; }
        (void)hipGetLastError();
        grid = cus;
    }
    if (grid < 0) return;
    Params p{};
    p.x_prompt = (const float*)d_in[0]; p.x_sample = (const float*)d_in[1]; p.state_in = (const float*)d_in[2]; p.lb_logits = (const float*)d_in[3]; p.norm_ffn1 = (const float*)d_in[4];
    p.f1w1 = (const float*)d_in[5]; p.f1w3 = (const float*)d_in[6]; p.f1w2 = (const float*)d_in[7]; p.norm_mix = (const float*)d_in[8]; p.w_in = (const float*)d_in[9];
    p.hgrn_gain = (const float*)d_in[10]; p.sgu_g = (const float*)d_in[11]; p.sgu_b = (const float*)d_in[12]; p.sgu_w = (const float*)d_in[13]; p.sgu_bs = (const float*)d_in[14];
    p.w_out = (const float*)d_in[15]; p.norm_ffn2 = (const float*)d_in[16]; p.f2w1 = (const float*)d_in[17]; p.f2w3 = (const float*)d_in[18]; p.f2w2 = (const float*)d_in[19]; p.final_norm = (const float*)d_in[20];
    p.out = (float*)d_out; p.ws = (unsigned char*)d_ws;
    void* args[] = {&p};
    hipError_t e = hipLaunchCooperativeKernel((const void*)fwd_megakernel, dim3(grid), dim3(NTHREADS), args, LDS_BYTES, stream);
    if (e != hipSuccess) fprintf(stderr, "kernel_launch: cooperative launch failed: %s (grid %d)\n", hipGetErrorString(e), grid);
}
```

```cpp
#include <hip/hip_runtime.h>
#include <hip/hip_cooperative_groups.h>
#include <cstdio>
#include <cstdint>
namespace cg = cooperative_groups;
namespace pg8 {
#define PG8_LAS __attribute__((address_space(3)))
typedef unsigned short bf16_t;
typedef short bf16x8 __attribute__((ext_vector_type(8)));
typedef float f32x4 __attribute__((ext_vector_type(4)));
typedef unsigned u32x4 __attribute__((ext_vector_type(4)));
constexpr int BM = 256, BK = 64, HALF = 128, HTB = HALF * BK * 2  , STAGE_BYTES = 8 * HTB, NXCD = 8, WGM = 8;

__host__ __device__ __forceinline__ int lds_byte(int r, int c) { const int st = (r >> 4) * 2 + (c >> 5), rr = r & 15, cc = c & 31, ob = rr * 64 + cc * 2; return st * 1024 + (ob ^ (((ob >> 9) & 1) << 5)); }
__host__ __device__ __forceinline__ void stage_rc(int b, int& R, int& C) { const int st = b / 1024, sb = b % 1024, swz = sb ^ (((sb >> 9) & 1) << 5); R = (st >> 1) * 16 + swz / 64; C = (st & 1) * 32 + (swz % 64) / 2; }
__host__ __device__ __forceinline__ int perm32(int rho) { const int n = rho >> 4, i = rho & 15; return 8 * (i >> 2) + 4 * n + (i & 3); }

struct Unit { int pm, pn; };
struct Gemm { const bf16_t* A; const bf16_t* Bt; int M, N, K; };

struct StaticOrder {
    int nM, nN, nwg, G, c;
    __host__ __device__ void init(int M, int N, int G_, int c_) { nM = M / BM; nN = N / BM; nwg = nM * nN; G = G_; c = c_; }
    __host__ __device__ bool next(int i, Unit& u) const {
        const long L = (long)i * G + c; if (L >= nwg) return false;
        int wgid = (int)L; { const int q = nwg / NXCD, r = nwg % NXCD, xcd = wgid % NXCD, off = wgid / NXCD; wgid = (xcd < r ? xcd * (q + 1) : r * (q + 1) + (xcd - r) * q) + off; }
        const int nig = WGM * nN, gid = wgid / nig, fm = gid * WGM, gsz = (nM - fm) < WGM ? (nM - fm) : WGM;
        u.pm = fm + ((wgid % nig) % gsz); u.pn = (wgid % nig) / gsz; return true;
    }
    __device__ __forceinline__ void a_ready(const Unit&) const {}
    __device__ __forceinline__ void done(const Unit&) const {}
};
__device__ __forceinline__ unsigned cvt_pk_bf16(float lo, float hi) { unsigned r; asm volatile("v_cvt_pk_bf16_f32 %0, %1, %2" : "=v"(r) : "v"(lo), "v"(hi)); return r; }
typedef unsigned u32x2 __attribute__((ext_vector_type(2)));
constexpr float RMS_EPS = 1e-6f;
__device__ __forceinline__ float silu_f(float x) { return x / (1.0f + __expf(-x)); }

__device__ __forceinline__ float row_rstd(const float* ssq, int row) {
    const f32x4* sp = (const f32x4*)(ssq + (size_t)row * 16); const f32x4 a = (sp[0] + sp[1]) + (sp[2] + sp[3]);
    return rsqrtf(((a[0] + a[1]) + (a[2] + a[3])) * (1.0f / 1024.0f) + RMS_EPS);
}
__device__ __forceinline__ void rows_rstd8(const float* ssq, int row0, int fq, float (&rs)[2][4]) {
    f32x4 sv[2][4];
#pragma unroll
    for (int ai = 0; ai < 2; ++ai)
#pragma unroll
        for (int m = 0; m < 4; ++m) sv[ai][m] = *(const f32x4*)(ssq + (size_t)(row0 + ai * HALF + m * 16) * 16 + 4 * fq);
#pragma unroll
    for (int ai = 0; ai < 2; ++ai)
#pragma unroll
        for (int m = 0; m < 4; ++m) { float s = (sv[ai][m][0] + sv[ai][m][1]) + (sv[ai][m][2] + sv[ai][m][3]); s += __shfl_xor(s, 16); s += __shfl_xor(s, 32); rs[ai][m] = rsqrtf(s * (1.0f / 1024.0f) + RMS_EPS); }
}
struct EpiSwiglu {
    static constexpr bool PERM = true, AFTER_DRAIN = false;
    bf16_t* O; int ldc; const float* ssq;
    __device__ __forceinline__ void operator()(const f32x4 (&acc)[2][2][4][2], const Unit& u, int wr, int wc, int fr, int fq) const {
        const int row0 = u.pm * BM + wr * 64 + fr, col0 = u.pn * HALF + wc * 32 + 8 * fq;
        float rs[2][4]; rows_rstd8(ssq, row0, fq, rs);
#pragma unroll
        for (int ai = 0; ai < 2; ++ai)
#pragma unroll
            for (int m = 0; m < 4; ++m) {
                const int row = row0 + ai * HALF + m * 16;
                float o[8];
#pragma unroll
                for (int n = 0; n < 2; ++n)
#pragma unroll
                    for (int j = 0; j < 4; ++j) { const float a = acc[ai][0][m][n][j] * rs[ai][m], b = acc[ai][1][m][n][j] * rs[ai][m]; o[n * 4 + j] = a * __builtin_amdgcn_rcpf(1.0f + __expf(-a)) * b; }
                u32x4 w; w.x = cvt_pk_bf16(o[0], o[1]); w.y = cvt_pk_bf16(o[2], o[3]); w.z = cvt_pk_bf16(o[4], o[5]); w.w = cvt_pk_bf16(o[6], o[7]);
                *(u32x4*)(O + (size_t)row * ldc + col0) = w;
            }
    }
};
struct EpiScale {
    static constexpr bool PERM = true, AFTER_DRAIN = false;
    bf16_t* O; int ldc; const float* ssq;
    __device__ __forceinline__ void operator()(const f32x4 (&acc)[2][2][4][2], const Unit& u, int wr, int wc, int fr, int fq) const {
        const int row0 = u.pm * BM + wr * 64 + fr, col0 = u.pn * BM + wc * 32 + 8 * fq;
        float rs[2][4]; rows_rstd8(ssq, row0, fq, rs);
#pragma unroll
        for (int ai = 0; ai < 2; ++ai)
#pragma unroll
            for (int m = 0; m < 4; ++m) {
                const int row = row0 + ai * HALF + m * 16;
#pragma unroll
                for (int bj = 0; bj < 2; ++bj) {
                    const f32x4 v0 = acc[ai][bj][m][0] * rs[ai][m], v1 = acc[ai][bj][m][1] * rs[ai][m];
                    u32x4 w; w.x = cvt_pk_bf16(v0[0], v0[1]); w.y = cvt_pk_bf16(v0[2], v0[3]); w.z = cvt_pk_bf16(v1[0], v1[1]); w.w = cvt_pk_bf16(v1[2], v1[3]);
                    *(u32x4*)(O + (size_t)row * ldc + col0 + bj * HALF) = w;
                }
            }
    }
};
struct EpiResid {
    static constexpr bool PERM = false, AFTER_DRAIN = false;
    float* X; bf16_t* XG; const float* g; float* ssq; float scale;
    __device__ __forceinline__ void operator()(const f32x4 (&acc)[2][2][4][2], const Unit& u, int wr, int wc, int fr, int fq) const {
        const int row0 = u.pm * BM + wr * 64 + fr, col0 = u.pn * BM + wc * 32 + 4 * fq;
        f32x4 gv[2][2];
#pragma unroll
        for (int bj = 0; bj < 2; ++bj)
#pragma unroll
            for (int n = 0; n < 2; ++n) gv[bj][n] = *(const f32x4*)(g + col0 + bj * HALF + n * 16);
        f32x4 xv[9][2][2];
#pragma unroll
        for (int bj = 0; bj < 2; ++bj)
#pragma unroll
            for (int n = 0; n < 2; ++n) xv[0][bj][n] = *(const f32x4*)(X + (size_t)row0 * 1024 + col0 + bj * HALF + n * 16);
#pragma unroll
        for (int gi = 0; gi < 8; ++gi) {
            const int ai = gi >> 2, m = gi & 3;
            const int row = row0 + ai * HALF + m * 16;
            if (gi + 1 < 8) { const int rown = row0 + ((gi + 1) >> 2) * HALF + ((gi + 1) & 3) * 16;
#pragma unroll
                for (int bj = 0; bj < 2; ++bj)
#pragma unroll
                    for (int n = 0; n < 2; ++n) xv[gi + 1][bj][n] = *(const f32x4*)(X + (size_t)rown * 1024 + col0 + bj * HALF + n * 16); }
            float* xr = X + (size_t)row * 1024 + col0; bf16_t* gr = XG + (size_t)row * 1024 + col0;
            float ss = 0.f;
#pragma unroll
            for (int bj = 0; bj < 2; ++bj)
#pragma unroll
                for (int n = 0; n < 2; ++n) {
                    const f32x4 x = xv[gi][bj][n] + acc[ai][bj][m][n] * scale;
                    *(f32x4*)(xr + bj * HALF + n * 16) = x;
                    ss += (x[0] * x[0] + x[1] * x[1]) + (x[2] * x[2] + x[3] * x[3]);
                    const f32x4 y = x * gv[bj][n];
                    u32x2 w; w.x = cvt_pk_bf16(y[0], y[1]); w.y = cvt_pk_bf16(y[2], y[3]);
                    *(u32x2*)(gr + bj * HALF + n * 16) = w;
                }
            ss += __shfl_xor(ss, 16); ss += __shfl_xor(ss, 32);
            if (fq == 0) ssq[(size_t)row * 16 + u.pn * 4 + wc] = ss;
        }
    }
};
template <class Epi, class Sched, bool ALIGN_EPI = false, bool SP2 = false>
__device__ __forceinline__ void gemm_phase(PG8_LAS unsigned char* lds, const Gemm g, const Sched& S, const Epi& E) {
    int tid_ = threadIdx.x; asm volatile("" : "+v"(tid_));
    const int tid = tid_, wid = __builtin_amdgcn_readfirstlane(tid >> 6), lane = tid & 63, wr = wid >> 2, wc = wid & 3, fr = lane & 15, fq = lane >> 4;
    const int K = g.K, nt = K / BK;
    unsigned voffA[2], voffB[2];
#pragma unroll
    for (int i = 0; i < 2; ++i) { int R, C; stage_rc(tid * 16 + i * 8192, R, C); const int Rb = Epi::PERM ? ((R & ~31) + perm32(R & 31)) : R;
        voffA[i] = (unsigned)(R * K + C) * 2u; voffB[i] = (unsigned)(Rb * K + C) * 2u; }
    const size_t kstep = (size_t)(BK * 2);
    const size_t hstep = (size_t)HALF * K * 2;
    const size_t tstep = 2 * hstep;
    const unsigned ldsw = (unsigned)wid * 1024u;
    const int aoff = lds_byte(wr * 64 + fr, fq * 8), boff = lds_byte(wc * 32 + fr, fq * 8);
#define PG8_SA(b, h) (((b) * 2 + (h)) * HTB)
#define PG8_SB(b, h) ((4 + (b) * 2 + (h)) * HTB)
#define PG8_STAGE(bufoff, gbase, voff) do { _Pragma("unroll") for (int _i = 0; _i < 2; ++_i) \
        __builtin_amdgcn_global_load_lds((const unsigned*)((const char*)(gbase) + (voff)[_i]), (PG8_LAS unsigned*)(lds + (bufoff) + ldsw + _i * 8192), 16, 0, 0); } while (0)
#define PG8_LDA(dst, b, h) do { _Pragma("unroll") for (int m = 0; m < 4; ++m) _Pragma("unroll") for (int k = 0; k < 2; ++k) dst[m][k] = *(const PG8_LAS bf16x8*)(lds + PG8_SA(b, h) + aoff + m * 2048 + k * 1024); } while (0)
#define PG8_LDB(dst, b, h) do { _Pragma("unroll") for (int n = 0; n < 2; ++n) _Pragma("unroll") for (int k = 0; k < 2; ++k) dst[n][k] = *(const PG8_LAS bf16x8*)(lds + PG8_SB(b, h) + boff + n * 2048 + k * 1024); } while (0)
#define PG8_MMA(ai, bj, At, Bt) do { __builtin_amdgcn_s_setprio(1); _Pragma("unroll") for (int m = 0; m < 4; ++m) _Pragma("unroll") for (int n = 0; n < 2; ++n) _Pragma("unroll") for (int k = 0; k < 2; ++k) \
        acc[ai][bj][m][n] = __builtin_amdgcn_mfma_f32_16x16x32_bf16(Bt[n][k], At[m][k], acc[ai][bj][m][n], 0, 0, 0); __builtin_amdgcn_s_setprio(0); } while (0)
#define PG8_WAIT_V(n) asm volatile("s_waitcnt vmcnt(" #n ")" ::: "memory")
#define PG8_WAIT_L(n) asm volatile("s_waitcnt lgkmcnt(" #n ")" ::: "memory")
#define PG8_BAR __builtin_amdgcn_s_barrier()
#define PG8_SCHED __builtin_amdgcn_sched_barrier(0)
    Unit cur, nxt; int ui = 0;
    if (!S.next(0, cur)) return;
    f32x4 acc[2][2][4][2];
#pragma unroll
    for (int a = 0; a < 2; ++a)
#pragma unroll
        for (int b = 0; b < 2; ++b)
#pragma unroll
            for (int m = 0; m < 4; ++m)
#pragma unroll
                for (int n = 0; n < 2; ++n) acc[a][b][m][n] = (f32x4){0.f, 0.f, 0.f, 0.f};
    bf16x8 At[4][2], B0[2][2], B1[2][2];
    const char* cA = (const char*)g.A + (size_t)cur.pm * tstep; const char* cB = (const char*)g.Bt + (size_t)cur.pn * tstep;
    S.a_ready(cur);
    if constexpr (SP2) {
        PG8_STAGE(PG8_SB(0, 0), cB, voffB); PG8_STAGE(PG8_SB(0, 1), cB + hstep, voffB); PG8_STAGE(PG8_SA(0, 0), cA, voffA); PG8_STAGE(PG8_SA(0, 1), cA + hstep, voffA);
        if (wr == 1) PG8_BAR;
        PG8_WAIT_V(2); PG8_BAR;
        PG8_STAGE(PG8_SB(1, 0), cB + kstep, voffB); PG8_STAGE(PG8_SA(1, 0), cA + kstep, voffA); PG8_STAGE(PG8_SB(1, 1), cB + hstep + kstep, voffB);
        PG8_WAIT_V(6); PG8_BAR;
    } else {
        PG8_STAGE(PG8_SB(0, 0), cB, voffB); PG8_STAGE(PG8_SA(0, 0), cA, voffA); PG8_STAGE(PG8_SB(0, 1), cB + hstep, voffB); PG8_STAGE(PG8_SA(0, 1), cA + hstep, voffA);
        if (wr == 1) PG8_BAR;
        PG8_WAIT_V(4); PG8_BAR;
        PG8_STAGE(PG8_SB(1, 0), cB + kstep, voffB); PG8_STAGE(PG8_SA(1, 0), cA + kstep, voffA); PG8_STAGE(PG8_SB(1, 1), cB + hstep + kstep, voffB);
        PG8_WAIT_V(6); PG8_BAR;
    }
    for (;;) {
        const bool has_next = S.next(ui + 1, nxt);
        const char* nA = has_next ? (const char*)g.A + (size_t)nxt.pm * tstep : cA; const char* nB = has_next ? (const char*)g.Bt + (size_t)nxt.pn * tstep : cB;
        for (int t = 0; t < nt; t += 2) {
            const bool last = (t == nt - 2);
            const char* a1 = cA + (size_t)(t + 1) * kstep;
            const char* a2 = last ? nA : cA + (size_t)(t + 2) * kstep; const char* b2 = last ? nB : cB + (size_t)(t + 2) * kstep;
            const char* a3 = a2 + kstep; const char* b3 = b2 + kstep;
            if (last && has_next) S.a_ready(nxt);
            if constexpr (SP2) {
            PG8_LDB(B0, 0, 0); PG8_LDB(B1, 0, 1); PG8_SCHED; PG8_LDA(At, 0, 0); PG8_STAGE(PG8_SA(1, 1), a1 + hstep, voffA);
            PG8_WAIT_V(8); PG8_WAIT_L(0); PG8_BAR; PG8_MMA(0, 0, At, B0); PG8_MMA(0, 1, At, B1); PG8_BAR; PG8_SCHED;
            PG8_LDA(At, 0, 1); PG8_STAGE(PG8_SB(0, 0), b2, voffB); PG8_STAGE(PG8_SB(0, 1), b2 + hstep, voffB); PG8_STAGE(PG8_SA(0, 0), a2, voffA);
            PG8_WAIT_V(8); PG8_WAIT_L(0); PG8_BAR; PG8_MMA(1, 0, At, B0); PG8_MMA(1, 1, At, B1); PG8_BAR; PG8_SCHED;
            PG8_LDB(B0, 1, 0); PG8_LDB(B1, 1, 1); PG8_SCHED; PG8_LDA(At, 1, 0); PG8_STAGE(PG8_SA(0, 1), a2 + hstep, voffA);
            PG8_WAIT_V(8); PG8_WAIT_L(0); PG8_BAR; PG8_MMA(0, 0, At, B0); PG8_MMA(0, 1, At, B1); PG8_BAR; PG8_SCHED;
            PG8_LDA(At, 1, 1); PG8_STAGE(PG8_SB(1, 0), b3, voffB); PG8_STAGE(PG8_SB(1, 1), b3 + hstep, voffB); PG8_STAGE(PG8_SA(1, 0), a3, voffA);
            PG8_WAIT_V(8); PG8_WAIT_L(0); PG8_BAR; PG8_MMA(1, 0, At, B0); PG8_MMA(1, 1, At, B1); PG8_BAR; PG8_SCHED;
            } else {
            PG8_LDB(B0, 0, 0); PG8_SCHED; PG8_LDA(At, 0, 0); PG8_STAGE(PG8_SA(1, 1), a1 + hstep, voffA);
            PG8_WAIT_L(8); PG8_BAR; PG8_WAIT_L(0); PG8_MMA(0, 0, At, B0); PG8_BAR; PG8_SCHED;
            PG8_LDB(B1, 0, 1); PG8_STAGE(PG8_SB(0, 0), b2, voffB);
            PG8_BAR; PG8_WAIT_L(0); PG8_MMA(0, 1, At, B1); PG8_BAR;
            PG8_LDA(At, 0, 1); PG8_STAGE(PG8_SA(0, 0), a2, voffA);
            PG8_BAR; PG8_WAIT_L(0); PG8_MMA(1, 0, At, B0); PG8_BAR; PG8_SCHED;
            PG8_STAGE(PG8_SB(0, 1), b2 + hstep, voffB);
            PG8_WAIT_V(6); PG8_BAR; PG8_MMA(1, 1, At, B1); PG8_BAR;
            PG8_LDB(B0, 1, 0); PG8_SCHED; PG8_LDA(At, 1, 0); PG8_STAGE(PG8_SA(0, 1), a2 + hstep, voffA);
            PG8_WAIT_L(8); PG8_BAR; PG8_WAIT_L(0); PG8_MMA(0, 0, At, B0); PG8_BAR; PG8_SCHED;
            PG8_LDB(B1, 1, 1); PG8_STAGE(PG8_SB(1, 0), b3, voffB);
            PG8_BAR; PG8_WAIT_L(0); PG8_MMA(0, 1, At, B1); PG8_BAR;
            PG8_LDA(At, 1, 1); PG8_STAGE(PG8_SA(1, 0), a3, voffA);
            PG8_BAR; PG8_WAIT_L(0); PG8_MMA(1, 0, At, B0); PG8_BAR; PG8_SCHED;
            PG8_STAGE(PG8_SB(1, 1), b3 + hstep, voffB);
            PG8_WAIT_V(6); PG8_BAR; PG8_MMA(1, 1, At, B1); PG8_BAR;
            }
        }
        if constexpr (ALIGN_EPI) { if (wr == 0) PG8_BAR; }
        if constexpr (!Epi::AFTER_DRAIN) { E(acc, cur, wr, wc, fr, fq); S.done(cur); }
        if (!has_next) break;
#pragma unroll
        for (int a = 0; a < 2; ++a)
#pragma unroll
            for (int b = 0; b < 2; ++b)
#pragma unroll
                for (int m = 0; m < 4; ++m)
#pragma unroll
                    for (int n = 0; n < 2; ++n) acc[a][b][m][n] = (f32x4){0.f, 0.f, 0.f, 0.f};
        cur = nxt; cA = nA; cB = nB; ++ui;
        if constexpr (ALIGN_EPI) { if (wr == 1) PG8_BAR; }
    }
    PG8_WAIT_V(0);
    if constexpr (!ALIGN_EPI) { if (wr == 0) PG8_BAR; }
    PG8_BAR;
    if constexpr (Epi::AFTER_DRAIN) { E.fused(acc, cur, wr, wc, fr, fq, lds, wid, lane); S.done(cur); }
#undef PG8_SA
#undef PG8_SB
#undef PG8_STAGE
#undef PG8_LDA
#undef PG8_LDB
#undef PG8_MMA
#undef PG8_WAIT_V
#undef PG8_WAIT_L
#undef PG8_BAR
#undef PG8_SCHED
}
}

#define LAS __attribute__((address_space(3)))
typedef unsigned short bf16;
typedef float f32x4 __attribute__((ext_vector_type(4)));
typedef short bf16x8 __attribute__((ext_vector_type(8)));
typedef unsigned u32x4 __attribute__((ext_vector_type(4)));
typedef unsigned u32x2 __attribute__((ext_vector_type(2)));

constexpr int DM = 1024, DFF = 2816, DIN = 3072, NL = 4;
constexpr int MP = 65536, MSMP = 2048, MROWS = MP + MSMP;
constexpr int NTHREADS = 512, NWAVES = 8;
constexpr int LDS_BYTES = 147456;
constexpr float EPS = 1e-6f;
constexpr size_t SZ_W13 = (size_t)2 * DFF * DM * 2, SZ_W2 = (size_t)DM * DFF * 2, SZ_WIN = (size_t)DIN * DM * 2, SZ_WOUT = (size_t)DM * DM * 2;
constexpr size_t OFF_W13A = 0, OFF_W2A = OFF_W13A + SZ_W13, OFF_WIN = OFF_W2A + SZ_W2, OFF_WOUT = OFF_WIN + SZ_WIN, OFF_W13B = OFF_WOUT + SZ_WOUT, OFF_W2B = OFF_W13B + SZ_W13;
constexpr size_t SZ_WLAYER = OFF_W2B + SZ_W2;
constexpr size_t WS_W = 0;
constexpr size_t WS_XG = ((WS_W + NL * SZ_WLAYER + 4095) / 4096) * 4096;
constexpr size_t WS_Z = WS_XG + (size_t)MROWS * DM * 2;
constexpr size_t WS_O = WS_Z + (size_t)MROWS * DIN * 2;
constexpr size_t WS_SSQ = WS_O + (size_t)MROWS * DM * 2;
constexpr size_t WS_CTR = WS_SSQ + (size_t)13 * MROWS * 16 * 4;
constexpr size_t WS_BAR = WS_CTR + 4096;
constexpr size_t WS_END = WS_BAR + 16384;
constexpr size_t OUT_STP = (size_t)MROWS * DM, OUT_STS = OUT_STP + (size_t)NL * 32 * 4 * 128 * 128, OUT_VS = OUT_STS + (size_t)NL * 32 * 4 * 128 * 128;

struct Params {
    const float *x_prompt, *x_sample, *state_in, *lb_logits, *norm_ffn1, *f1w1, *f1w3, *f1w2, *norm_mix, *w_in, *hgrn_gain, *sgu_g, *sgu_b, *sgu_w, *sgu_bs, *w_out, *norm_ffn2, *f2w1, *f2w3, *f2w2, *final_norm;
    float* out; unsigned char* ws;
};

__device__ __forceinline__ float bf2f(bf16 v) { return __uint_as_float(((unsigned)v) << 16); }
__device__ __forceinline__ unsigned f2bf(float f) { unsigned u = __float_as_uint(f); return (u + 0x7fffu + ((u >> 16) & 1u)) >> 16; }
__device__ __forceinline__ unsigned pk2(float lo, float hi) { return pg8::cvt_pk_bf16(lo, hi); }
__device__ __forceinline__ float lo_f(unsigned w) { return __uint_as_float(w << 16); }
__device__ __forceinline__ float hi_f(unsigned w) { return __uint_as_float(w & 0xffff0000u); }
__device__ __forceinline__ float silu_f(float x) { return x / (1.0f + __expf(-x)); }
__device__ __forceinline__ float gelu_f(float x) { const float u = 1.5957691216f * (x + 0.044715f * x * x * x); return x / (1.0f + __expf(-u)); }
__device__ __forceinline__ float wave_sum(float v) {
#pragma unroll
    for (int o = 1; o < 64; o <<= 1) v += __shfl_xor(v, o);
    return v;
}
#define LDS_WAIT() asm volatile("s_waitcnt lgkmcnt(0)" ::: "memory")
#define MFMA16(a, b, c) __builtin_amdgcn_mfma_f32_16x16x32_bf16((a), (b), (c), 0, 0, 0)

#define XB_TMO      128
#define XB_XCNT(j)  (256  + 64 * (j))
#define XB_XSUB(j)  (1280 + 64 * (j))
#define XB_XGEN(j)  (2304 + 64 * (j))
#define XB_TOP      3328
#define XB_TOPGEN   3392
#define XCD_BAR_WORDS 3456
#define XB_SPIN_CAP (1u << 18)

__device__ __forceinline__ unsigned xb_ld(unsigned* p)              { return __hip_atomic_load(p, __ATOMIC_RELAXED, __HIP_MEMORY_SCOPE_AGENT); }
__device__ __forceinline__ unsigned xb_add(unsigned* p, unsigned v) { return __hip_atomic_fetch_add(p, v, __ATOMIC_RELAXED, __HIP_MEMORY_SCOPE_AGENT); }
__device__ __forceinline__ unsigned xb_xcc_id() { return (unsigned)__builtin_amdgcn_s_getreg((3 << 11) | 20) & 0xFu; }
#define XB_SPIN(cond, bar) do { unsigned _sp = 0; while (cond) { __builtin_amdgcn_s_sleep(1); \
    if ((++_sp & 255u) == 0u) { if (xb_ld(&(bar)[XB_TMO])) break; if (_sp > XB_SPIN_CAP) { atomicAdd(&(bar)[XB_TMO], 1u); break; } } } } while (0)

struct XcdBarrier {
    unsigned* bar; unsigned x;
    volatile LAS unsigned* st;
};

__device__ __forceinline__ XcdBarrier xcd_barrier_post(unsigned* bar, volatile LAS unsigned* st) {
    XcdBarrier b; b.bar = bar; b.x = xb_xcc_id(); b.st = st;
    if (threadIdx.x == 0) (void)xb_add(&bar[XB_XCNT(b.x)], 1u);
    return b;
}
__device__ __forceinline__ void xcd_barrier_complete(unsigned* bar, unsigned x, unsigned& nloc, unsigned& nx) {
    const unsigned G = gridDim.x * gridDim.y * gridDim.z;
    unsigned sum, cnt, mine, sp = 0u;
    for (;;) {
        sum = 0u; cnt = 0u; mine = 0u;
#pragma unroll
        for (unsigned j = 0; j < 16; ++j) { const unsigned c = xb_ld(&bar[XB_XCNT(j)]); sum += c; cnt += (c > 0u) ? 1u : 0u; mine = (j == x) ? c : mine; }
        if (sum == G) break;
        __builtin_amdgcn_s_sleep(1);
        if ((++sp & 255u) == 0u) { if (xb_ld(&bar[XB_TMO])) break; if (sp > XB_SPIN_CAP) { atomicAdd(&bar[XB_TMO], 1u); break; } }
    }
    nloc = mine > 0u ? mine : 1u; nx = cnt > 0u ? cnt : 1u;
}

__device__ __forceinline__ void xcd_barrier(const XcdBarrier& b) {
    asm volatile("s_waitcnt vmcnt(0)" ::: "memory");
    __syncthreads();
    if (threadIdx.x == 0) {
        unsigned* bar = b.bar;
        __builtin_amdgcn_s_waitcnt(0);
        unsigned nloc = b.st[0], nx = b.st[1];
        if (nloc == 0u) { xcd_barrier_complete(bar, b.x, nloc, nx); b.st[0] = nloc; b.st[1] = nx; }
        const unsigned old = xb_add(&bar[XB_XSUB(b.x)], 1u);
        const unsigned gen = old / nloc;
        if (old + 1u == (gen + 1u) * nloc) {
            __builtin_amdgcn_fence(__ATOMIC_RELEASE, "agent");
            asm volatile("s_waitcnt vmcnt(0)" ::: "memory");
            const unsigned og = xb_add(&bar[XB_TOP], 1u);
            const unsigned tg = og / nx;
            if (og + 1u == (tg + 1u) * nx) xb_add(&bar[XB_TOPGEN], 1u);
            else XB_SPIN(xb_ld(&bar[XB_TOPGEN]) == tg, bar);
            __builtin_amdgcn_fence(__ATOMIC_ACQUIRE, "agent");
            xb_add(&bar[XB_XGEN(b.x)], 1u);
            asm volatile("s_waitcnt vmcnt(0)" ::: "memory");
        } else {
            XB_SPIN(xb_ld(&bar[XB_XGEN(b.x)]) == gen, bar);
            __builtin_amdgcn_fence(__ATOMIC_ACQUIRE, "agent");
            asm volatile("s_waitcnt vmcnt(0)" ::: "memory");
        }
    }
    __syncthreads();
}

__device__ __forceinline__ void tr_item(const float* W, int K, int N, bf16* WT, int k0, int n0, int drow0, LAS float* scr, int lane) {
#pragma unroll 8
    for (int i = 0; i < 32; ++i) { const int kk = 2 * i + (lane >> 5); scr[kk * 33 + (lane & 31)] = W[(size_t)(k0 + kk) * N + n0 + (lane & 31)]; }
    LDS_WAIT();
    const int c = lane & 7;
#pragma unroll
    for (int j = 0; j < 4; ++j) { const int n = (lane >> 3) + 8 * j; const LAS float* s = scr + (8 * c) * 33 + n;
        u32x4 o; o.x = pk2(s[0 * 33], s[1 * 33]); o.y = pk2(s[2 * 33], s[3 * 33]); o.z = pk2(s[4 * 33], s[5 * 33]); o.w = pk2(s[6 * 33], s[7 * 33]);
        *(u32x4*)(WT + (size_t)(drow0 + n) * K + k0 + 8 * c) = o; }
    LDS_WAIT();
}
__device__ __forceinline__ void prologue(LAS unsigned char* lds, const Params& p) {
    int tid_ = threadIdx.x; asm volatile("" : "+v"(tid_)); const int tid = tid_, lane = tid & 63, wave = tid >> 6;
    const int gw = blockIdx.x * NWAVES + wave, NGW = gridDim.x * NWAVES;
    LAS float* scr = (LAS float*)(lds + wave * 16384);
    constexpr int I_UP = (DM / 64) * (DFF / 32), I_DN = (DFF / 64) * (DM / 32), I_IN = (DM / 64) * (DIN / 32), I_OUT = (DM / 64) * (DM / 32);
    constexpr int I_LAYER = 6 * I_UP + I_IN + I_OUT;
    static_assert(I_UP == I_DN, "item counts");
    for (int it = gw; it < NL * I_LAYER; it += NGW) {
        const int l = it / I_LAYER; int r = it % I_LAYER;
        bf16* wl = (bf16*)(p.ws + WS_W + (size_t)l * SZ_WLAYER);
        const size_t oup = (size_t)l * DM * DFF, oin = (size_t)l * DM * DIN, oout = (size_t)l * DM * DM;
        if (r < 2 * I_UP) {
            const int w3 = r >= I_UP; r -= w3 * I_UP; const int kb = r / (DFF / 32), nb = r % (DFF / 32), n0 = 32 * nb;
            tr_item((w3 ? p.f1w3 : p.f1w1) + oup, DM, DFF, (bf16*)((unsigned char*)wl + OFF_W13A), 64 * kb, n0, (n0 >> 7) * 256 + (n0 & 127) + w3 * 128 - 0, scr, lane); continue; }
        r -= 2 * I_UP;
        if (r < I_DN) { const int kb = r / (DM / 32), nb = r % (DM / 32); tr_item(p.f1w2 + oup, DFF, DM, (bf16*)((unsigned char*)wl + OFF_W2A), 64 * kb, 32 * nb, 32 * nb, scr, lane); continue; }
        r -= I_DN;
        if (r < I_IN) { const int kb = r / (DIN / 32), nb = r % (DIN / 32); tr_item(p.w_in + oin, DM, DIN, (bf16*)((unsigned char*)wl + OFF_WIN), 64 * kb, 32 * nb, 32 * nb, scr, lane); continue; }
        r -= I_IN;
        if (r < I_OUT) { const int kb = r / (DM / 32), nb = r % (DM / 32); tr_item(p.w_out + oout, DM, DM, (bf16*)((unsigned char*)wl + OFF_WOUT), 64 * kb, 32 * nb, 32 * nb, scr, lane); continue; }
        r -= I_OUT;
        if (r < 2 * I_UP) {
            const int w3 = r >= I_UP; r -= w3 * I_UP; const int kb = r / (DFF / 32), nb = r % (DFF / 32), n0 = 32 * nb;
            tr_item((w3 ? p.f2w3 : p.f2w1) + oup, DM, DFF, (bf16*)((unsigned char*)wl + OFF_W13B), 64 * kb, n0, (n0 >> 7) * 256 + (n0 & 127) + w3 * 128, scr, lane); continue; }
        r -= 2 * I_UP;
        { const int kb = r / (DM / 32), nb = r % (DM / 32); tr_item(p.f2w2 + oup, DFF, DM, (bf16*)((unsigned char*)wl + OFF_W2B), 64 * kb, 32 * nb, 32 * nb, scr, lane); }
    }
    float* X = p.out; bf16* XG = (bf16*)(p.ws + WS_XG); float* ssq = (float*)(p.ws + WS_SSQ);
    for (int m = gw; m < MROWS; m += NGW) {
        const float* src = m < MP ? p.x_prompt + (size_t)m * DM : p.x_sample + (size_t)(m - MP) * DM;
        float ss = 0.f;
#pragma unroll
        for (int j = 0; j < 4; ++j) {
            const f32x4 v = ((const f32x4*)src)[lane + 64 * j]; const f32x4 g = ((const f32x4*)p.norm_ffn1)[lane + 64 * j];
            ss += (v[0] * v[0] + v[1] * v[1]) + (v[2] * v[2] + v[3] * v[3]);
            ((f32x4*)(X + (size_t)m * DM))[lane + 64 * j] = v;
            u32x2 w; w.x = pk2(v[0] * g[0], v[1] * g[1]); w.y = pk2(v[2] * g[2], v[3] * g[3]);
            ((u32x2*)(XG + (size_t)m * DM))[lane + 64 * j] = w;
        }
        ss = wave_sum(ss);
        if (lane < 16) ssq[(size_t)m * 16 + lane] = lane == 0 ? ss : 0.f;
    }
    if (blockIdx.x == 0) { if (tid < 64) ((unsigned*)(p.ws + WS_CTR))[tid] = 0u; for (int i = tid; i < XCD_BAR_WORDS; i += NTHREADS) ((unsigned*)(p.ws + WS_BAR))[i] = 0u; }
}

constexpr int H_QA = 0, H_KA = 17408, H_KAT = 34816, H_VT = 53248, H_P = 71680, H_ST = 80896, H_SEG = 115712, H_EREF = 119808, H_DEC = 120320, H_SC = 120832, H_RS = 121344;
constexpr int PQ = 136, PT = 72;
#define WG_BAR() do { asm volatile("s_waitcnt lgkmcnt(0)" ::: "memory"); __builtin_amdgcn_s_barrier(); asm volatile("" ::: "memory"); } while (0)
__device__ __forceinline__ float sigm_f(float x) { return __builtin_amdgcn_rcpf(1.0f + __expf(-x)); }
__device__ __forceinline__ void hgrn_seq(LAS unsigned char* lds, const Params& p, int l, int b, int h, bool samp) {
    int tid_ = threadIdx.x; asm volatile("" : "+v"(tid_)); const int tid = tid_, lane = tid & 63, w = tid >> 6, fr = lane & 15, fq = lane >> 4;
    LAS bf16* QA = (LAS bf16*)(lds + H_QA); LAS bf16* KA = (LAS bf16*)(lds + H_KA); LAS bf16* KAT = (LAS bf16*)(lds + H_KAT); LAS bf16* VT = (LAS bf16*)(lds + H_VT);
    LAS bf16* PP = (LAS bf16*)(lds + H_P); LAS bf16* ST = (LAS bf16*)(lds + H_ST);
    LAS float* SEG = (LAS float*)(lds + H_SEG); LAS float* EREF = (LAS float*)(lds + H_EREF); LAS float* DEC = (LAS float*)(lds + H_DEC); LAS float* SC = (LAS float*)(lds + H_SC); LAS float* RS = (LAS float*)(lds + H_RS);
    const bf16* Z = (const bf16*)(p.ws + WS_Z); bf16* O = (bf16*)(p.ws + WS_O);
    typedef float f32x2 __attribute__((ext_vector_type(2)));
    float lbv0, lbv1;
    { const float* lg = p.lb_logits + h * 128 + 2 * lane; const f32x2 a0 = *(const f32x2*)lg, a1 = *(const f32x2*)(lg + 512), a2 = *(const f32x2*)(lg + 1024), a3 = *(const f32x2*)(lg + 1536);
      { const float mx = fmaxf(fmaxf(a0.x, a1.x), fmaxf(a2.x, a3.x)); const float e0 = __expf(a0.x - mx), e1 = __expf(a1.x - mx), e2 = __expf(a2.x - mx), e3 = __expf(a3.x - mx);
        lbv0 = ((l >= 1 ? e1 : 0.f) + (l >= 2 ? e2 : 0.f) + (l >= 3 ? e3 : 0.f)) / (e0 + e1 + e2 + e3); }
      { const float mx = fmaxf(fmaxf(a0.y, a1.y), fmaxf(a2.y, a3.y)); const float e0 = __expf(a0.y - mx), e1 = __expf(a1.y - mx), e2 = __expf(a2.y - mx), e3 = __expf(a3.y - mx);
        lbv1 = ((l >= 1 ? e1 : 0.f) + (l >= 2 ? e2 : 0.f) + (l >= 3 ? e3 : 0.f)) / (e0 + e1 + e2 + e3); } }
    const size_t sbase = (size_t)((l * 32 + b) * 4 + h) * 16384;
    f32x4 S[8];
#pragma unroll
    for (int kt = 0; kt < 8; ++kt)
#pragma unroll
        for (int r = 0; r < 4; ++r) S[kt][r] = samp ? p.state_in[sbase + (size_t)(kt * 16 + 4 * fq + r) * 128 + w * 16 + fr] : 0.f;
    const int nch = samp ? 1 : 32, rbase = samp ? MP + b * 64 : b * 2048;
    const int tt = w & 3, vt0 = (w >> 2) * 4;
    f32x4 gq[4];
#pragma unroll
    for (int j = 0; j < 4; ++j) gq[j] = *(const f32x4*)(p.hgrn_gain + l * 512 + h * 128 + (vt0 + j) * 16 + 4 * fq);
    unsigned cq[8], cf[8], ci[8];
    { const bf16* zp = Z + (size_t)(rbase + w * 8) * DIN + h * 128 + 2 * lane;
#pragma unroll
      for (int i = 0; i < 8; ++i) { cq[i] = *(const unsigned*)(zp + (size_t)i * DIN); cf[i] = *(const unsigned*)(zp + (size_t)i * DIN + 512); ci[i] = *(const unsigned*)(zp + (size_t)i * DIN + 1024); } }
#pragma unroll 1
    for (int n = 0; n < nch; ++n) {
        const int rowc = rbase + n * 64;
        u32x2 zgp[4];
#pragma unroll
        for (int j = 0; j < 4; ++j) zgp[j] = *(const u32x2*)(Z + (size_t)(rowc + tt * 16 + fr) * DIN + 1536 + h * 128 + (vt0 + j) * 16 + 4 * fq);
        float bl0[8], bl1[8], qv0[8], qv1[8], kv0[8], kv1[8]; unsigned vv[8];
        float run0 = 0.f, run1 = 0.f;
#pragma unroll
        for (int i = 0; i < 8; ++i) {
            const float f0 = lbv0 + (1.0f - lbv0) * sigm_f(lo_f(cf[i])), f1 = lbv1 + (1.0f - lbv1) * sigm_f(hi_f(cf[i]));
            run0 += __logf(f0); run1 += __logf(f1); bl0[i] = run0; bl1[i] = run1; kv0[i] = 1.0f - f0; kv1[i] = 1.0f - f1;
            const float zq0 = lo_f(cq[i]), zq1 = hi_f(cq[i]);
            qv0[i] = zq0 * sigm_f(zq0) * 0.08838834764831845f; qv1[i] = zq1 * sigm_f(zq1) * 0.08838834764831845f; vv[i] = ci[i]; }
        *(LAS f32x2*)(SEG + w * 128 + 2 * lane) = (f32x2){run0, run1};
        if (n + 1 < nch) {
            const bf16* zp = Z + (size_t)(rowc + 64 + w * 8) * DIN + h * 128 + 2 * lane;
#pragma unroll
            for (int i = 0; i < 8; ++i) { cq[i] = *(const unsigned*)(zp + (size_t)i * DIN); cf[i] = *(const unsigned*)(zp + (size_t)i * DIN + 512); ci[i] = *(const unsigned*)(zp + (size_t)i * DIN + 1024); } }
        WG_BAR();
        { float pre0 = 0.f, pre1 = 0.f, ref0 = 0.f, ref1 = 0.f, tot0 = 0.f, tot1 = 0.f;
#pragma unroll
          for (int s = 0; s < 8; ++s) { const f32x2 sv = *(const LAS f32x2*)(SEG + s * 128 + 2 * lane);
              if (s < w) { pre0 += sv.x; pre1 += sv.y; } if (s < 4) { ref0 += sv.x; ref1 += sv.y; } tot0 += sv.x; tot1 += sv.y; }
          unsigned kat0[4], kat1[4], vt0w[4], vt1w[4];
#pragma unroll
          for (int i = 0; i < 8; i += 2) {
              float ka0[2], ka1[2];
#pragma unroll
              for (int e = 0; e < 2; ++e) {
                  const float d0 = pre0 + bl0[i + e] - ref0, d1 = pre1 + bl1[i + e] - ref1;
                  const float qa0 = qv0[i + e] * __expf(fminf(d0, 80.f)), qa1 = qv1[i + e] * __expf(fminf(d1, 80.f));
                  ka0[e] = kv0[i + e] * __expf(fminf(-d0, 80.f)); ka1[e] = kv1[i + e] * __expf(fminf(-d1, 80.f));
                  *(LAS unsigned*)(QA + (w * 8 + i + e) * PQ + 2 * lane) = pk2(qa0, qa1);
                  *(LAS unsigned*)(KA + (w * 8 + i + e) * PQ + 2 * lane) = pk2(ka0[e], ka1[e]); }
              kat0[i >> 1] = pk2(ka0[0], ka0[1]); kat1[i >> 1] = pk2(ka1[0], ka1[1]);
              vt0w[i >> 1] = (vv[i] & 0xffffu) | (vv[i + 1] << 16); vt1w[i >> 1] = (vv[i] >> 16) | (vv[i + 1] & 0xffff0000u); }
          *(LAS u32x4*)(KAT + (2 * lane) * PT + w * 8) = (u32x4){kat0[0], kat0[1], kat0[2], kat0[3]}; *(LAS u32x4*)(KAT + (2 * lane + 1) * PT + w * 8) = (u32x4){kat1[0], kat1[1], kat1[2], kat1[3]};
          *(LAS u32x4*)(VT + (2 * lane) * PT + w * 8) = (u32x4){vt0w[0], vt0w[1], vt0w[2], vt0w[3]}; *(LAS u32x4*)(VT + (2 * lane + 1) * PT + w * 8) = (u32x4){vt1w[0], vt1w[1], vt1w[2], vt1w[3]};
          if (w == 0) { *(LAS f32x2*)(EREF + 2 * lane) = (f32x2){__expf(ref0), __expf(ref1)}; *(LAS f32x2*)(DEC + 2 * lane) = (f32x2){__expf(tot0), __expf(tot1)}; *(LAS f32x2*)(SC + 2 * lane) = (f32x2){__expf(tot0 - ref0), __expf(tot1 - ref1)}; } }
        WG_BAR();
#pragma unroll
        for (int kt = 0; kt < 8; ++kt) { const int k0 = kt * 16 + 4 * fq; const f32x4 er = *(const LAS f32x4*)(EREF + k0);
            u32x2 wv; wv.x = pk2(S[kt][0] * er[0], S[kt][1] * er[1]); wv.y = pk2(S[kt][2] * er[2], S[kt][3] * er[3]);
            *(LAS u32x2*)(ST + (w * 16 + fr) * PQ + k0) = wv; }
        { const int pt = w >> 1;
#pragma unroll
          for (int j = 0; j < 2; ++j) { const int st = (w & 1) * 2 + j; f32x4 a4 = (f32x4){0.f, 0.f, 0.f, 0.f};
              if (st <= pt) {
#pragma unroll
                  for (int ks = 0; ks < 4; ++ks) { const bf16x8 a = *(const LAS bf16x8*)(KA + (st * 16 + fr) * PQ + ks * 32 + fq * 8); const bf16x8 bb = *(const LAS bf16x8*)(QA + (pt * 16 + fr) * PQ + ks * 32 + fq * 8); a4 = MFMA16(a, bb, a4); } }
              const int t = pt * 16 + fr, s0 = st * 16 + 4 * fq;
              u32x2 wv; wv.x = pk2(s0 + 0 <= t ? a4[0] : 0.f, s0 + 1 <= t ? a4[1] : 0.f); wv.y = pk2(s0 + 2 <= t ? a4[2] : 0.f, s0 + 3 <= t ? a4[3] : 0.f);
              *(LAS u32x2*)(PP + t * PT + s0) = wv; } }
        WG_BAR();
        f32x4 oacc[4];
#pragma unroll
        for (int j = 0; j < 4; ++j) oacc[j] = (f32x4){0.f, 0.f, 0.f, 0.f};
#pragma unroll
        for (int ks = 0; ks < 4; ++ks) { const bf16x8 bb = *(const LAS bf16x8*)(QA + (tt * 16 + fr) * PQ + ks * 32 + fq * 8);
#pragma unroll
            for (int j = 0; j < 4; ++j) { const bf16x8 a = *(const LAS bf16x8*)(ST + ((vt0 + j) * 16 + fr) * PQ + ks * 32 + fq * 8); oacc[j] = MFMA16(a, bb, oacc[j]); } }
#pragma unroll
        for (int ks = 0; ks < 2; ++ks) { const bf16x8 bb = *(const LAS bf16x8*)(PP + (tt * 16 + fr) * PT + ks * 32 + fq * 8);
#pragma unroll
            for (int j = 0; j < 4; ++j) { const bf16x8 a = *(const LAS bf16x8*)(VT + ((vt0 + j) * 16 + fr) * PT + ks * 32 + fq * 8); oacc[j] = MFMA16(a, bb, oacc[j]); } }
        { float ss = 0.f;
#pragma unroll
          for (int j = 0; j < 4; ++j) ss += (oacc[j][0] * oacc[j][0] + oacc[j][1] * oacc[j][1]) + (oacc[j][2] * oacc[j][2] + oacc[j][3] * oacc[j][3]);
          ss += __shfl_xor(ss, 16); ss += __shfl_xor(ss, 32);
          if (fq == 0) RS[(w >> 2) * 64 + tt * 16 + fr] = ss; }
        { f32x4 pacc[8];
#pragma unroll
          for (int kt = 0; kt < 8; ++kt) pacc[kt] = (f32x4){0.f, 0.f, 0.f, 0.f};
#pragma unroll
          for (int ks = 0; ks < 2; ++ks) { const bf16x8 bb = *(const LAS bf16x8*)(VT + (w * 16 + fr) * PT + ks * 32 + fq * 8);
#pragma unroll
              for (int kt = 0; kt < 8; ++kt) { const bf16x8 a = *(const LAS bf16x8*)(KAT + (kt * 16 + fr) * PT + ks * 32 + fq * 8); pacc[kt] = MFMA16(a, bb, pacc[kt]); } }
#pragma unroll
          for (int kt = 0; kt < 8; ++kt) { const int k0 = kt * 16 + 4 * fq; const f32x4 de = *(const LAS f32x4*)(DEC + k0), sc = *(const LAS f32x4*)(SC + k0); S[kt] = de * S[kt] + sc * pacc[kt]; } }
        WG_BAR();
        { const int t = tt * 16 + fr; const float rstd = rsqrtf((RS[t] + RS[64 + t]) * (1.0f / 128.0f) + EPS);
          bf16* op = O + (size_t)(rowc + t) * DM + h * 128 + 4 * fq;
#pragma unroll
          for (int j = 0; j < 4; ++j) { const float g0 = lo_f(zgp[j].x), g1 = hi_f(zgp[j].x), g2 = lo_f(zgp[j].y), g3 = hi_f(zgp[j].y);
              u32x2 o; o.x = pk2(oacc[j][0] * rstd * gq[j][0] * (g0 * sigm_f(g0)), oacc[j][1] * rstd * gq[j][1] * (g1 * sigm_f(g1)));
              o.y = pk2(oacc[j][2] * rstd * gq[j][2] * (g2 * sigm_f(g2)), oacc[j][3] * rstd * gq[j][3] * (g3 * sigm_f(g3)));
              *(u32x2*)(op + (vt0 + j) * 16) = o; } }
    }
    WG_BAR();
    float* so = p.out + (samp ? OUT_STS : OUT_STP) + sbase;
#pragma unroll
    for (int kt = 0; kt < 8; ++kt)
#pragma unroll
        for (int r = 0; r < 4; ++r) so[(size_t)(kt * 16 + 4 * fq + r) * 128 + w * 16 + fr] = S[kt][r];
}

constexpr int G_WT = 0, G_VNT = 34816, G_BS = 69632;
__device__ __forceinline__ void sgu_unit(LAS unsigned char* lds, const Params& p, int l, int u) {
    int tid_ = threadIdx.x; asm volatile("" : "+v"(tid_)); const int tid = tid_, lane = tid & 63, w = tid >> 6, fr = lane & 15, fq = lane >> 4;
    const bool samp = u >= 2048; const int us = samp ? u - 2048 : u; const int hs = us & 3, ch = us >> 2;
    const int C = samp ? 64 : 128, row0 = samp ? MP + ch * 64 : ch * 128;
    LAS bf16* WT = (LAS bf16*)(lds + G_WT); LAS bf16* VNT = (LAS bf16*)(lds + G_VNT); LAS float* BS = (LAS float*)(lds + G_BS);
    const bf16* Z = (const bf16*)(p.ws + WS_Z); bf16* O = (bf16*)(p.ws + WS_O);
    const int t4 = tid >> 2, q0 = (tid & 3) * 32;
    if (t4 < C) {
        const float* wsrc = p.sgu_w + (size_t)(l * 4 + hs) * 16384 + t4 * 128 + q0;
#pragma unroll
        for (int q = 0; q < 4; ++q) { const f32x4 a = *(const f32x4*)(wsrc + 8 * q), bq = *(const f32x4*)(wsrc + 8 * q + 4); const int s = q0 + 8 * q;
            u32x4 o; o.x = pk2(s + 0 <= t4 ? a[0] : 0.f, s + 1 <= t4 ? a[1] : 0.f); o.y = pk2(s + 2 <= t4 ? a[2] : 0.f, s + 3 <= t4 ? a[3] : 0.f);
            o.z = pk2(s + 4 <= t4 ? bq[0] : 0.f, s + 5 <= t4 ? bq[1] : 0.f); o.w = pk2(s + 6 <= t4 ? bq[2] : 0.f, s + 7 <= t4 ? bq[3] : 0.f);
            *(LAS u32x4*)(WT + t4 * PQ + s) = o; }
        const u32x4* zv = (const u32x4*)(Z + (size_t)(row0 + t4) * DIN + 2560 + hs * 128 + q0);
        float v[32]; float sm = 0.f;
#pragma unroll
        for (int q = 0; q < 4; ++q) { const u32x4 zw = zv[q];
#pragma unroll
            for (int e = 0; e < 4; ++e) { v[q * 8 + e * 2] = gelu_f(lo_f(zw[e])); v[q * 8 + e * 2 + 1] = gelu_f(hi_f(zw[e])); sm += v[q * 8 + e * 2] + v[q * 8 + e * 2 + 1]; } }
        sm += __shfl_xor(sm, 1); sm += __shfl_xor(sm, 2);
        const float mu = sm * (1.0f / 128.0f); float vs = 0.f;
#pragma unroll
        for (int j = 0; j < 32; ++j) { v[j] -= mu; vs += v[j] * v[j]; }
        vs += __shfl_xor(vs, 1); vs += __shfl_xor(vs, 2);
        const float rstd = rsqrtf(vs * (1.0f / 128.0f) + EPS);
        const float* lg = p.sgu_g + l * 512 + hs * 128 + q0; const float* lb = p.sgu_b + l * 512 + hs * 128 + q0;
        float* vo = p.out + OUT_VS + ((size_t)(l * 32 + ch) * 64 + t4) * 512 + hs * 128 + q0;
#pragma unroll
        for (int q = 0; q < 8; ++q) { const f32x4 g4 = *(const f32x4*)(lg + 4 * q), b4 = *(const f32x4*)(lb + 4 * q); f32x4 r;
#pragma unroll
            for (int e = 0; e < 4; ++e) { r[e] = v[4 * q + e] * rstd * g4[e] + b4[e]; VNT[(q0 + 4 * q + e) * PQ + t4] = (bf16)f2bf(r[e]); }
            if (samp) *(f32x4*)(vo + 4 * q) = r; }
    }
    if (tid < 128) BS[tid] = p.sgu_bs[(l * 4 + hs) * 128 + tid];
    __syncthreads();
    if (w * 16 < C) {
        const int nks = (w >> 1) + 1;
        f32x4 acc[8];
#pragma unroll
        for (int dt = 0; dt < 8; ++dt) acc[dt] = (f32x4){0.f, 0.f, 0.f, 0.f};
#pragma unroll 1
        for (int ks = 0; ks < nks; ++ks) { const bf16x8 bb = *(const LAS bf16x8*)(WT + (w * 16 + fr) * PQ + ks * 32 + fq * 8);
#pragma unroll
            for (int dt = 0; dt < 8; ++dt) { const bf16x8 a = *(const LAS bf16x8*)(VNT + (dt * 16 + fr) * PQ + ks * 32 + fq * 8); acc[dt] = MFMA16(a, bb, acc[dt]); } }
        const int t = w * 16 + fr; const float bias = BS[t];
        const bf16* zu = Z + (size_t)(row0 + t) * DIN + 2048 + hs * 128; bf16* op = O + (size_t)(row0 + t) * DM + 512 + hs * 128;
#pragma unroll
        for (int dt = 0; dt < 8; ++dt) { const int d = dt * 16 + 4 * fq; const u32x2 zw = *(const u32x2*)(zu + d);
            u32x2 o; o.x = pk2(gelu_f(lo_f(zw.x)) * (acc[dt][0] + bias), gelu_f(hi_f(zw.x)) * (acc[dt][1] + bias)); o.y = pk2(gelu_f(lo_f(zw.y)) * (acc[dt][2] + bias), gelu_f(hi_f(zw.y)) * (acc[dt][3] + bias));
            *(u32x2*)(op + d) = o; }
    }
    __syncthreads();
}

__device__ __forceinline__ void mixer_phase(LAS unsigned char* lds, const Params& p, int l, int rep = 0) {
#ifndef HGRN_REPEAT
#define HGRN_REPEAT 1
#endif
#pragma unroll 1
    for (int hr = 0; hr < HGRN_REPEAT; ++hr)
    for (int q = blockIdx.x; q < 256; q += gridDim.x) { if (q < 128) hgrn_seq(lds, p, l, q >> 2, q & 3, false); else hgrn_seq(lds, p, l, (q - 128) >> 2, (q - 128) & 3, true); }

    LAS int* slot = (LAS int*)(lds + LDS_BYTES - 256);
    unsigned* ctr = (unsigned*)(p.ws + WS_CTR) + l + 4 * rep;
    for (;;) {
        __syncthreads();
        if (threadIdx.x == 0) *slot = (int)atomicAdd(ctr, 1u);
        __syncthreads();
        const int u = *slot;
        if (u >= 2048 + 128) break;
        sgu_unit(lds, p, l, u);
    }
}

__device__ __forceinline__ void final_norm_phase(const Params& p) {
    int tid_ = threadIdx.x; asm volatile("" : "+v"(tid_)); const int tid = tid_, lane = tid & 63, wave = tid >> 6;
    const int gw = blockIdx.x * NWAVES + wave, NGW = gridDim.x * NWAVES;
    const float* ssq = (const float*)(p.ws + WS_SSQ) + (size_t)12 * MROWS * 16;
    for (int m = gw; m < MROWS; m += NGW) {
        const float rs = pg8::row_rstd(ssq, m);
        f32x4* xr = (f32x4*)(p.out + (size_t)m * DM);
#pragma unroll
        for (int j = 0; j < 4; ++j) { const f32x4 v = xr[lane + 64 * j]; const f32x4 g = ((const f32x4*)p.final_norm)[lane + 64 * j]; xr[lane + 64 * j] = v * rs * g; }
    }
}

__global__ void __launch_bounds__(NTHREADS, 2) fwd_megakernel(Params p) {
    extern __shared__ __attribute__((aligned(16))) unsigned char lds_raw[];
    LAS unsigned char* lds = (LAS unsigned char*)lds_raw;
    cg::grid_group grid = cg::this_grid();
    const int G = gridDim.x, bid = blockIdx.x;
    float* X = p.out; bf16* XG = (bf16*)(p.ws + WS_XG); bf16* ZB = (bf16*)(p.ws + WS_Z); bf16* OB = (bf16*)(p.ws + WS_O); float* ssq = (float*)(p.ws + WS_SSQ);
    volatile LAS unsigned* bst = (volatile LAS unsigned*)(lds + LDS_BYTES - 128);
    if (threadIdx.x == 0) { bst[0] = 0u; bst[1] = 0u; }
    prologue(lds, p);
    grid.sync();
    const XcdBarrier bar = xcd_barrier_post((unsigned*)(p.ws + WS_BAR), bst);
#pragma unroll 1
    for (int l = 0; l < NL; ++l) {
        const unsigned char* wl = p.ws + WS_W + (size_t)l * SZ_WLAYER;
        {
            pg8::Gemm g{XG, (const bf16*)(wl + OFF_W13A), MROWS, 2 * DFF, DM}; pg8::StaticOrder S; S.init(MROWS, 2 * DFF, G, bid);
            pg8::EpiSwiglu E{ZB, DFF, ssq + (size_t)(3 * l) * MROWS * 16};
            pg8::gemm_phase<pg8::EpiSwiglu, pg8::StaticOrder, true, true>(lds, g, S, E);
        }
        xcd_barrier(bar);
        {
            pg8::Gemm g{ZB, (const bf16*)(wl + OFF_W2A), MROWS, DM, DFF}; pg8::StaticOrder S; S.init(MROWS, DM, G, bid);
            pg8::EpiResid E{X, XG, p.norm_mix + l * DM, ssq + (size_t)(3 * l + 1) * MROWS * 16, 0.5f};
            pg8::gemm_phase<pg8::EpiResid, pg8::StaticOrder, true, true>(lds, g, S, E);
        }
        xcd_barrier(bar);
        {
            pg8::Gemm g{XG, (const bf16*)(wl + OFF_WIN), MROWS, DIN, DM}; pg8::StaticOrder S; S.init(MROWS, DIN, G, bid);
            pg8::EpiScale E{ZB, DIN, ssq + (size_t)(3 * l + 1) * MROWS * 16};
            pg8::gemm_phase<pg8::EpiScale, pg8::StaticOrder, true, true>(lds, g, S, E);
        }
        xcd_barrier(bar);
#ifndef MIX_REPEAT
#define MIX_REPEAT 1
#endif
#pragma unroll 1
        for (int rep = 0; rep < MIX_REPEAT; ++rep) { mixer_phase(lds, p, l, rep); xcd_barrier(bar); }
        {
            pg8::Gemm g{OB, (const bf16*)(wl + OFF_WOUT), MROWS, DM, DM}; pg8::StaticOrder S; S.init(MROWS, DM, G, bid);
            pg8::EpiResid E{X, XG, p.norm_ffn2 + l * DM, ssq + (size_t)(3 * l + 2) * MROWS * 16, 1.0f};
            pg8::gemm_phase<pg8::EpiResid, pg8::StaticOrder, true, true>(lds, g, S, E);
        }
        xcd_barrier(bar);
        {
            pg8::Gemm g{XG, (const bf16*)(wl + OFF_W13B), MROWS, 2 * DFF, DM}; pg8::StaticOrder S; S.init(MROWS, 2 * DFF, G, bid);
            pg8::EpiSwiglu E{ZB, DFF, ssq + (size_t)(3 * l + 2) * MROWS * 16};
            pg8::gemm_phase<pg8::EpiSwiglu, pg8::StaticOrder, true, true>(lds, g, S, E);
        }
        xcd_barrier(bar);
        {
            pg8::Gemm g{ZB, (const bf16*)(wl + OFF_W2B), MROWS, DM, DFF}; pg8::StaticOrder S; S.init(MROWS, DM, G, bid);
            pg8::EpiResid E{X, XG, l < NL - 1 ? p.norm_ffn1 + (l + 1) * DM : p.final_norm, ssq + (size_t)(3 * l + 3) * MROWS * 16, 0.5f};
            pg8::gemm_phase<pg8::EpiResid, pg8::StaticOrder, true, true>(lds, g, S, E);
        }
        xcd_barrier(bar);
    }
    final_norm_phase(p);
}

extern "C" void kernel_launch(void* const* d_in, const int* in_sizes, int n_in, void* d_out, int out_size, void* d_ws, size_t ws_size, hipStream_t stream) {
    static int grid = 0;
    if (grid == 0) {
        if (n_in != 21 || ws_size < WS_END) { fprintf(stderr, "kernel_launch: unexpected n_in %d or ws_size %zu (need %zu)\n", n_in, ws_size, (size_t)WS_END); grid = -1; return; }
        if (hipFuncSetAttribute((const void*)fwd_megakernel, hipFuncAttributeMaxDynamicSharedMemorySize, LDS_BYTES) != hipSuccess) { fprintf(stderr, "kernel_launch: hipFuncSetAttribute failed\n"); grid = -1; return; }
        int dev = 0, cus = 0, per_cu = 0;
        hipGetDevice(&dev); hipDeviceGetAttribute(&cus, hipDeviceAttributeMultiprocessorCount, dev);
        hipOccupancyMaxActiveBlocksPerMultiprocessor(&per_cu, (const void*)fwd_megakernel, NTHREADS, LDS_BYTES);
        if (per_cu < 1) { fprintf(stderr, "kernel_launch: occupancy query says %d blocks per CU\n", per_cu); per_cu = 1; }
        (void)hipGetLastError();
        grid = cus;
    }
    if (grid < 0) return;
    Params p{};
    p.x_prompt = (const float*)d_in[0]; p.x_sample = (const float*)d_in[1]; p.state_in = (const float*)d_in[2]; p.lb_logits = (const float*)d_in[3]; p.norm_ffn1 = (const float*)d_in[4];
    p.f1w1 = (const float*)d_in[5]; p.f1w3 = (const float*)d_in[6]; p.f1w2 = (const float*)d_in[7]; p.norm_mix = (const float*)d_in[8]; p.w_in = (const float*)d_in[9];
    p.hgrn_gain = (const float*)d_in[10]; p.sgu_g = (const float*)d_in[11]; p.sgu_b = (const float*)d_in[12]; p.sgu_w = (const float*)d_in[13]; p.sgu_bs = (const float*)d_in[14];
    p.w_out = (const float*)d_in[15]; p.norm_ffn2 = (const float*)d_in[16]; p.f2w1 = (const float*)d_in[17]; p.f2w3 = (const float*)d_in[18]; p.f2w2 = (const float*)d_in[19]; p.final_norm = (const float*)d_in[20];
    p.out = (float*)d_out; p.ws = (unsigned char*)d_ws;
    void* args[] = {&p};
    hipError_t e = hipLaunchCooperativeKernel((const void*)fwd_megakernel, dim3(grid), dim3(NTHREADS), args, LDS_BYTES, stream);
    if (e != hipSuccess) fprintf(stderr, "kernel_launch: cooperative launch failed: %s (grid %d)\n", hipGetErrorString(e), grid);
}
```
